# Optimizing an MI355X kernel written in HIP

```python
import math
import jax, jax.numpy as jnp
from jax import lax
import numpy as np

D_MODEL = 1024
BATCH = 16
SEQ = 2048
DEPTH = 1

HEAD_DIM = 64
SB_HEADS = 8
DIL_PAIRS = ((128, 1), (512, 4), (2048, 16))
DIL_HEADS_PER_GROUP = 4
DIL_HEADS = DIL_HEADS_PER_GROUP * len(DIL_PAIRS)
SB_WIDTH = SB_HEADS * HEAD_DIM
DIL_WIDTH = DIL_HEADS * HEAD_DIM
DIL_OUT_WIDTH = DIL_HEADS_PER_GROUP * HEAD_DIM
IN_WIDTH = 3 * SB_WIDTH + 3 * DIL_WIDTH + 2 * D_MODEL
D_FF = ((8 * D_MODEL + 3 * 256 - 1) // (3 * 256)) * 256
Q_BLOCK = 128
RMS_EPS = 1e-6
ALIBI_MAX_BIAS = 8.0
SPLITS = tuple(int(c) for c in np.cumsum([SB_WIDTH, SB_WIDTH, SB_WIDTH, DIL_WIDTH, DIL_WIDTH, DIL_WIDTH, D_MODEL]))

kernel_name = "hybrid_stickbreak_dilated_gated"


def rms_norm(x, g):
    xf = x.astype(jnp.float32)
    y = xf * lax.rsqrt(jnp.mean(xf * xf, axis=-1, keepdims=True) + RMS_EPS) * g.astype(jnp.float32)
    return y.astype(x.dtype)


def alibi_slopes(n):
    return jnp.exp2(-ALIBI_MAX_BIAS * jnp.arange(1, n + 1, dtype=jnp.float32) / n)


def stick_breaking_attention(q, k, v):
    b, s, h, dh = q.shape
    nb = s // Q_BLOCK
    scale = 1.0 / math.sqrt(dh)
    qb = q.reshape(b, nb, Q_BLOCK, h, dh).transpose(1, 0, 3, 2, 4)
    kpos = jnp.arange(s)

    def block(args):
        q_blk, t0 = args
        z = jnp.einsum('bhqd,bkhd->bhqk', q_blk, k, preferred_element_type=jnp.float32) * scale
        tpos = t0 + jnp.arange(Q_BLOCK)
        causal = kpos[None, :] < tpos[:, None]
        log_keep = jnp.where(causal, jax.nn.log_sigmoid(-z), 0.0)
        log_after = lax.cumsum(log_keep, axis=3, reverse=True) - log_keep
        a = jnp.where(causal, jnp.exp(jax.nn.log_sigmoid(z) + log_after), 0.0)
        return jnp.einsum('bhqk,bkhd->bqhd', a.astype(v.dtype), v)

    out = lax.map(block, (qb, jnp.arange(nb) * Q_BLOCK))
    return out.transpose(1, 0, 2, 3, 4).reshape(b, s, h * dh)


def dilated_group_attention(q, k, v, window, dilation, slopes):
    b, s, h, dh = q.shape
    L = s // dilation
    w = window // dilation
    blk = w
    nb = -(-L // blk)
    lp = nb * blk

    def to_sub(t):
        t = t.reshape(b, L, dilation, h, dh).transpose(0, 2, 3, 1, 4)
        return jnp.pad(t, ((0, 0), (0, 0), (0, 0), (0, lp - L), (0, 0)))

    def band(t):
        t = jnp.pad(t, ((0, 0), (0, 0), (0, 0), (blk, 0), (0, 0))).reshape(b, dilation, h, nb + 1, blk, dh)
        return jnp.concatenate([t[:, :, :, :-1], t[:, :, :, 1:]], axis=4)

    qb = to_sub(q).reshape(b, dilation, h, nb, blk, dh)
    kb = band(to_sub(k))
    vb = band(to_sub(v))
    scores = jnp.einsum('brhnqd,brhnkd->brhnqk', qb, kb, preferred_element_type=jnp.float32) / math.sqrt(dh)
    qa = jnp.arange(blk)
    kc = jnp.arange(2 * blk)
    dist = blk + qa[:, None] - kc[None, :]
    key_idx = (jnp.arange(nb)[:, None] - 1) * blk + kc[None, :]
    valid = ((dist >= 0) & (dist <= w))[None, :, :] & (key_idx >= 0)[:, None, :]
    scores = scores - slopes[:, None, None, None] * (dist * dilation).astype(jnp.float32)
    scores = jnp.where(valid, scores, -jnp.inf)
    m = scores.max(-1)
    p = jnp.exp(scores - m[..., None])
    l = p.sum(-1)
    num = jnp.einsum('brhnqk,brhnkd->brhnqd', p, vb.astype(jnp.float32))

    def from_sub(t):
        t = t.reshape((b, dilation, h, lp) + t.shape[5:])[:, :, :, :L]
        t = jnp.moveaxis(t, 3, 1)
        return t.reshape((b, s, h) + t.shape[4:])

    return from_sub(num), from_sub(m), from_sub(l)


def dilated_mixture_attention(q, k, v):
    b, s, _, dh = q.shape
    slopes = alibi_slopes(DIL_HEADS)
    nums, ms, ls = [], [], []
    for g, (window, dilation) in enumerate(DIL_PAIRS):
        sl = slice(g * DIL_HEADS_PER_GROUP, (g + 1) * DIL_HEADS_PER_GROUP)
        n_g, m_g, l_g = dilated_group_attention(q[:, :, sl], k[:, :, sl], v[:, :, sl], window, dilation, slopes[sl])
        nums.append(n_g); ms.append(m_g); ls.append(l_g)
    m = jnp.stack(ms)
    wts = jnp.exp(m - m.max(0))
    den = (wts * jnp.stack(ls)).sum(0)
    num = (wts[..., None] * jnp.stack(nums)).sum(0)
    out = num / den[..., None]
    return out.reshape(b, s, DIL_OUT_WIDTH)


def setup_inputs(seed: int = 0) -> dict:
    key = jax.random.key(seed)
    ks = jax.random.split(key, 11)
    f32 = jnp.float32

    def nrm(k, shape, fan_in):
        return jax.random.normal(k, shape, f32) * (fan_in ** -0.5)

    return {
        "x": jax.random.normal(ks[0], (BATCH, SEQ, D_MODEL), f32),
        "norm_mix_g": 1.0 + 0.01 * jax.random.normal(ks[1], (DEPTH, D_MODEL), f32),
        "w_in": nrm(ks[2], (DEPTH, D_MODEL, IN_WIDTH), D_MODEL),
        "w_sb_up": nrm(ks[3], (DEPTH, SB_WIDTH, D_MODEL), SB_WIDTH),
        "w_dil_up": nrm(ks[4], (DEPTH, DIL_OUT_WIDTH, D_MODEL), DIL_OUT_WIDTH),
        "w_out": nrm(ks[5], (DEPTH, D_MODEL, D_MODEL), D_MODEL),
        "norm_ffn_g": 1.0 + 0.01 * jax.random.normal(ks[6], (DEPTH, D_MODEL), f32),
        "w_ffn_in": nrm(ks[7], (DEPTH, D_MODEL, 2 * D_FF), D_MODEL),
        "w_ffn_out": nrm(ks[8], (DEPTH, D_FF, D_MODEL), D_FF),
        "norm_final_g": 1.0 + 0.01 * jax.random.normal(ks[9], (D_MODEL,), f32),
    }


def reference(x, norm_mix_g, w_in, w_sb_up, w_dil_up, w_out, norm_ffn_g, w_ffn_in, w_ffn_out, norm_final_g):
    b, s, _ = x.shape
    for i in range(DEPTH):
        u = rms_norm(x, norm_mix_g[i])
        proj = u @ w_in[i]
        q_sb, k_sb, v_sb, q_dl, k_dl, v_dl, gate_sb, gate_dl = jnp.split(proj, SPLITS, axis=-1)
        heads_sb = lambda t: t.reshape(b, s, SB_HEADS, HEAD_DIM)
        heads_dl = lambda t: t.reshape(b, s, DIL_HEADS, HEAD_DIM)
        o_sb = stick_breaking_attention(heads_sb(q_sb), heads_sb(k_sb), heads_sb(v_sb))
        o_dl = dilated_mixture_attention(heads_dl(q_dl), heads_dl(k_dl), heads_dl(v_dl)).astype(x.dtype)
        y_sb = o_sb @ w_sb_up[i]
        y_dl = o_dl @ w_dil_up[i]
        merged = jax.nn.sigmoid(gate_sb) * y_sb + jax.nn.sigmoid(gate_dl) * y_dl
        x = x + merged @ w_out[i]
        u2 = rms_norm(x, norm_ffn_g[i])
        g_ff, up_ff = jnp.split(u2 @ w_ffn_in[i], 2, axis=-1)
        x = x + (jax.nn.silu(g_ff) * up_ff) @ w_ffn_out[i]
    return rms_norm(x, norm_final_g)
```

```cpp
#include <hip/hip_runtime.h>
#include <hip/hip_cooperative_groups.h>
#include <cstdio>
#include <cstdint>
namespace cg = cooperative_groups;
#ifndef MK_N_LAUNCHES
#define MK_N_LAUNCHES 1
#endif
#ifndef SB_EARLY_EXIT
#define SB_EARLY_EXIT 1
#endif
namespace pg8 {
#define PG8_LAS __attribute__((address_space(3)))
typedef unsigned short bf16_t;
typedef short bf16x8 __attribute__((ext_vector_type(8)));
typedef float f32x4 __attribute__((ext_vector_type(4)));
typedef unsigned u32x4 __attribute__((ext_vector_type(4)));
constexpr int BM = 256, BK = 64, HALF = 128, HTB = HALF * BK * 2  , STAGE_BYTES = 8 * HTB, NXCD = 8, WGM = 8;

__host__ __device__ __forceinline__ int lds_byte(int r, int c) { const int st = (r >> 4) * 2 + (c >> 5), rr = r & 15, cc = c & 31, ob = rr * 64 + cc * 2; return st * 1024 + (ob ^ (((ob >> 9) & 1) << 5)); }
__host__ __device__ __forceinline__ void stage_rc(int b, int& R, int& C) { const int st = b / 1024, sb = b % 1024, swz = sb ^ (((sb >> 9) & 1) << 5); R = (st >> 1) * 16 + swz / 64; C = (st & 1) * 32 + (swz % 64) / 2; }
__host__ __device__ __forceinline__ int perm32(int rho) { const int n = rho >> 4, i = rho & 15; return 8 * (i >> 2) + 4 * n + (i & 3); }

struct Unit { int pm, pn; };
struct Gemm { const bf16_t* A; const bf16_t* Bt; int M, N, K; };

struct StaticOrder {
    int nM, nN, nwg, G, c;
    __host__ __device__ void init(int M, int N, int G_, int c_) { nM = M / BM; nN = N / BM; nwg = nM * nN; G = G_; c = c_; }
    __host__ __device__ bool next(int i, Unit& u) const {
        const long L = (long)i * G + c; if (L >= nwg) return false;
        int wgid = (int)L; { const int q = nwg / NXCD, r = nwg % NXCD, xcd = wgid % NXCD, off = wgid / NXCD; wgid = (xcd < r ? xcd * (q + 1) : r * (q + 1) + (xcd - r) * q) + off; }
        const int nig = WGM * nN, gid = wgid / nig, fm = gid * WGM, gsz = (nM - fm) < WGM ? (nM - fm) : WGM;
        u.pm = fm + ((wgid % nig) % gsz); u.pn = (wgid % nig) / gsz; return true;
    }
    __device__ __forceinline__ void a_ready(const Unit&) const {}
    __device__ __forceinline__ void done(const Unit&) const {}
};

__device__ __forceinline__ unsigned cvt_pk_bf16(float lo, float hi) { unsigned r; asm volatile("v_cvt_pk_bf16_f32 %0, %1, %2" : "=v"(r) : "v"(lo), "v"(hi)); return r; }
typedef float f32x2 __attribute__((ext_vector_type(2)));
__device__ __forceinline__ float bflo(unsigned w) { return __uint_as_float(w << 16); }
__device__ __forceinline__ float bfhi(unsigned w) { return __uint_as_float(w & 0xffff0000u); }
__device__ __forceinline__ unsigned pkbf(float lo, float hi) { typedef float f2 __attribute__((ext_vector_type(2))); typedef __bf16 b2 __attribute__((ext_vector_type(2))); f2 v = {lo, hi}; b2 b = __builtin_convertvector(v, b2); return __builtin_bit_cast(unsigned, b); }
__device__ __forceinline__ float sigm(float x) { return __builtin_amdgcn_rcpf(1.0f + __builtin_amdgcn_exp2f(-1.4426950408889634f * x)); }
__device__ __forceinline__ u32x4 pack8(const f32x4 v0, const f32x4 v1) { u32x4 w; w.x = pkbf(v0[0], v0[1]); w.y = pkbf(v0[2], v0[3]); w.z = pkbf(v1[0], v1[1]); w.w = pkbf(v1[2], v1[3]); return w; }

struct EpiStore {
    static constexpr bool PERM = true, AFTER_DRAIN = false;
    bf16_t* O; int ldc;
    __device__ __forceinline__ void operator()(const f32x4 (&acc)[2][2][4][2], const Unit& u, int wr, int wc, int fr, int fq) const {
        const int row0 = u.pm * BM + wr * 64 + fr, col0 = u.pn * BM + wc * 32 + 8 * fq;
#pragma unroll
        for (int ai = 0; ai < 2; ++ai)
#pragma unroll
            for (int m = 0; m < 4; ++m) { bf16_t* rowp = O + (size_t)(row0 + ai * HALF + m * 16) * ldc + col0;
#pragma unroll
                for (int bj = 0; bj < 2; ++bj) *(u32x4*)(rowp + bj * HALF) = pack8(acc[ai][bj][m][0], acc[ai][bj][m][1]); }
    }
};
struct EpiGate {
    static constexpr bool PERM = true, AFTER_DRAIN = false;
    bf16_t* O; const bf16_t* add; const bf16_t* gate; int ldg;
    __device__ __forceinline__ void operator()(const f32x4 (&acc)[2][2][4][2], const Unit& u, int wr, int wc, int fr, int fq) const {
        const int row0 = u.pm * BM + wr * 64 + fr, col0 = u.pn * BM + wc * 32 + 8 * fq;
#pragma unroll
        for (int ai = 0; ai < 2; ++ai)
#pragma unroll
            for (int m = 0; m < 4; ++m) { const size_t row = (size_t)(row0 + ai * HALF + m * 16);
#pragma unroll
                for (int bj = 0; bj < 2; ++bj) { const int col = col0 + bj * HALF;
                    const u32x4 g = *(const u32x4*)(gate + row * ldg + col);
                    u32x4 a = (u32x4){0u, 0u, 0u, 0u}; if (add) a = *(const u32x4*)(add + row * 1024 + col);
                    const f32x4 v0 = acc[ai][bj][m][0], v1 = acc[ai][bj][m][1];
                    f32x4 o0, o1;
                    o0[0] = bflo(a.x) + sigm(bflo(g.x)) * v0[0]; o0[1] = bfhi(a.x) + sigm(bfhi(g.x)) * v0[1];
                    o0[2] = bflo(a.y) + sigm(bflo(g.y)) * v0[2]; o0[3] = bfhi(a.y) + sigm(bfhi(g.y)) * v0[3];
                    o1[0] = bflo(a.z) + sigm(bflo(g.z)) * v1[0]; o1[1] = bfhi(a.z) + sigm(bfhi(g.z)) * v1[1];
                    o1[2] = bflo(a.w) + sigm(bflo(g.w)) * v1[2]; o1[3] = bfhi(a.w) + sigm(bfhi(g.w)) * v1[3];
                    *(u32x4*)(O + row * 1024 + col) = pack8(o0, o1); } }
    }
};
template <bool WRITE_XB> struct EpiResid {
    static constexpr bool PERM = true, AFTER_DRAIN = false;
    const float* X; float* X1; bf16_t* XB; float* ssq;
    __device__ __forceinline__ void operator()(const f32x4 (&acc)[2][2][4][2], const Unit& u, int wr, int wc, int fr, int fq) const {
        const int row0 = u.pm * BM + wr * 64 + fr, col0 = u.pn * BM + wc * 32 + 8 * fq;
#pragma unroll
        for (int ai = 0; ai < 2; ++ai)
#pragma unroll
            for (int m = 0; m < 4; ++m) { const size_t row = (size_t)(row0 + ai * HALF + m * 16); float ss = 0.f;
#pragma unroll
                for (int bj = 0; bj < 2; ++bj) { const size_t off = row * 1024 + col0 + bj * HALF;
                    const f32x4 a = *(const f32x4*)(X + off), b = *(const f32x4*)(X + off + 4);
                    const f32x4 v0 = acc[ai][bj][m][0] + a, v1 = acc[ai][bj][m][1] + b;
                    *(f32x4*)(X1 + off) = v0; *(f32x4*)(X1 + off + 4) = v1;
                    if (WRITE_XB) *(u32x4*)(XB + off) = pack8(v0, v1);
                    ss += (v0[0] * v0[0] + v0[1] * v0[1]) + (v0[2] * v0[2] + v0[3] * v0[3]) + (v1[0] * v1[0] + v1[1] * v1[1]) + (v1[2] * v1[2] + v1[3] * v1[3]); }
                ss += __shfl_xor(ss, 16); ss += __shfl_xor(ss, 32);
                if (fq == 0) unsafeAtomicAdd(ssq + row, ss); }
    }
};
struct EpiSwiGLU {
    static constexpr bool PERM = true, AFTER_DRAIN = false;
    bf16_t* H; const float* ssq;
    __device__ __forceinline__ void operator()(const f32x4 (&acc)[2][2][4][2], const Unit& u, int wr, int wc, int fr, int fq) const {
        const int row0 = u.pm * BM + wr * 64 + fr, col0 = u.pn * HALF + wc * 32 + 8 * fq;
#pragma unroll
        for (int ai = 0; ai < 2; ++ai)
#pragma unroll
            for (int m = 0; m < 4; ++m) { const size_t row = (size_t)(row0 + ai * HALF + m * 16);
                const float rstd = __builtin_amdgcn_rsqf(ssq[row] * (1.0f / 1024.0f) + 1e-6f);
                f32x4 h0, h1;
#pragma unroll
                for (int e = 0; e < 4; ++e) { const float g0 = acc[ai][0][m][0][e] * rstd, g1 = acc[ai][0][m][1][e] * rstd;
                    h0[e] = g0 * sigm(g0) * (acc[ai][1][m][0][e] * rstd); h1[e] = g1 * sigm(g1) * (acc[ai][1][m][1][e] * rstd); }
                *(u32x4*)(H + row * 2816 + col0) = pack8(h0, h1); }
    }
};

template <class Epi, class Sched, bool ALIGN_EPI = false, bool SP2 = false>
__device__ __forceinline__ void gemm_phase(PG8_LAS unsigned char* lds, const Gemm g, const Sched& S, const Epi& E) {
    const int tid = threadIdx.x, wid = __builtin_amdgcn_readfirstlane(tid >> 6), lane = tid & 63, wr = wid >> 2, wc = wid & 3, fr = lane & 15, fq = lane >> 4;
    const int K = g.K, nt = K / BK;
    unsigned voffA[2], voffB[2];
#pragma unroll
    for (int i = 0; i < 2; ++i) { int R, C; stage_rc(tid * 16 + i * 8192, R, C); const int Rb = Epi::PERM ? ((R & ~31) + perm32(R & 31)) : R;
        voffA[i] = (unsigned)(R * K + C) * 2u; voffB[i] = (unsigned)(Rb * K + C) * 2u; }
    const size_t kstep = (size_t)(BK * 2);
    const size_t hstep = (size_t)HALF * K * 2;
    const size_t tstep = 2 * hstep;
    const unsigned ldsw = (unsigned)wid * 1024u;
    const int aoff = lds_byte(wr * 64 + fr, fq * 8), boff = lds_byte(wc * 32 + fr, fq * 8);
#define PG8_SA(b, h) (((b) * 2 + (h)) * HTB)
#define PG8_SB(b, h) ((4 + (b) * 2 + (h)) * HTB)
#define PG8_STAGE(bufoff, gbase, voff) do { _Pragma("unroll") for (int _i = 0; _i < 2; ++_i) \
        __builtin_amdgcn_global_load_lds((const unsigned*)((const char*)(gbase) + (voff)[_i]), (PG8_LAS unsigned*)(lds + (bufoff) + ldsw + _i * 8192), 16, 0, 0); } while (0)
#define PG8_LDA(dst, b, h) do { _Pragma("unroll") for (int m = 0; m < 4; ++m) _Pragma("unroll") for (int k = 0; k < 2; ++k) dst[m][k] = *(const PG8_LAS bf16x8*)(lds + PG8_SA(b, h) + aoff + m * 2048 + k * 1024); } while (0)
#define PG8_LDB(dst, b, h) do { _Pragma("unroll") for (int n = 0; n < 2; ++n) _Pragma("unroll") for (int k = 0; k < 2; ++k) dst[n][k] = *(const PG8_LAS bf16x8*)(lds + PG8_SB(b, h) + boff + n * 2048 + k * 1024); } while (0)
#define PG8_MMA(ai, bj, At, Bt) do { __builtin_amdgcn_s_setprio(1); _Pragma("unroll") for (int m = 0; m < 4; ++m) _Pragma("unroll") for (int n = 0; n < 2; ++n) _Pragma("unroll") for (int k = 0; k < 2; ++k) \
        acc[ai][bj][m][n] = __builtin_amdgcn_mfma_f32_16x16x32_bf16(Bt[n][k], At[m][k], acc[ai][bj][m][n], 0, 0, 0); __builtin_amdgcn_s_setprio(0); } while (0)
#define PG8_WAIT_V(n) asm volatile("s_waitcnt vmcnt(" #n ")" ::: "memory")
#define PG8_WAIT_L(n) asm volatile("s_waitcnt lgkmcnt(" #n ")" ::: "memory")
#define PG8_BAR __builtin_amdgcn_s_barrier()
#define PG8_SCHED __builtin_amdgcn_sched_barrier(0)
    Unit cur, nxt; int ui = 0;
    if (!S.next(0, cur)) return;
    f32x4 acc[2][2][4][2];
#pragma unroll
    for (int a = 0; a < 2; ++a)
#pragma unroll
        for (int b = 0; b < 2; ++b)
#pragma unroll
            for (int m = 0; m < 4; ++m)
#pragma unroll
                for (int n = 0; n < 2; ++n) acc[a][b][m][n] = (f32x4){0.f, 0.f, 0.f, 0.f};
    bf16x8 At[4][2], B0[2][2], B1[2][2];
    const char* cA = (const char*)g.A + (size_t)cur.pm * tstep; const char* cB = (const char*)g.Bt + (size_t)cur.pn * tstep;
    S.a_ready(cur);
    if constexpr (SP2) {
        PG8_STAGE(PG8_SB(0, 0), cB, voffB); PG8_STAGE(PG8_SB(0, 1), cB + hstep, voffB); PG8_STAGE(PG8_SA(0, 0), cA, voffA); PG8_STAGE(PG8_SA(0, 1), cA + hstep, voffA);
        if (wr == 1) PG8_BAR;
        PG8_WAIT_V(2); PG8_BAR;
        PG8_STAGE(PG8_SB(1, 0), cB + kstep, voffB); PG8_STAGE(PG8_SA(1, 0), cA + kstep, voffA); PG8_STAGE(PG8_SB(1, 1), cB + hstep + kstep, voffB);
        PG8_WAIT_V(6); PG8_BAR;
    } else {
        PG8_STAGE(PG8_SB(0, 0), cB, voffB); PG8_STAGE(PG8_SA(0, 0), cA, voffA); PG8_STAGE(PG8_SB(0, 1), cB + hstep, voffB); PG8_STAGE(PG8_SA(0, 1), cA + hstep, voffA);
        if (wr == 1) PG8_BAR;
        PG8_WAIT_V(4); PG8_BAR;
        PG8_STAGE(PG8_SB(1, 0), cB + kstep, voffB); PG8_STAGE(PG8_SA(1, 0), cA + kstep, voffA); PG8_STAGE(PG8_SB(1, 1), cB + hstep + kstep, voffB);
        PG8_WAIT_V(6); PG8_BAR;
    }
    for (;;) {
        const bool has_next = S.next(ui + 1, nxt);
        const char* nA = has_next ? (const char*)g.A + (size_t)nxt.pm * tstep : cA; const char* nB = has_next ? (const char*)g.Bt + (size_t)nxt.pn * tstep : cB;
        for (int t = 0; t < nt; t += 2) {
            const bool last = (t == nt - 2);
            const char* a1 = cA + (size_t)(t + 1) * kstep;
            const char* a2 = last ? nA : cA + (size_t)(t + 2) * kstep; const char* b2 = last ? nB : cB + (size_t)(t + 2) * kstep;
            const char* a3 = a2 + kstep; const char* b3 = b2 + kstep;
            if (last && has_next) S.a_ready(nxt);
            if constexpr (SP2) {
            PG8_LDB(B0, 0, 0); PG8_LDB(B1, 0, 1); PG8_SCHED; PG8_LDA(At, 0, 0); PG8_STAGE(PG8_SA(1, 1), a1 + hstep, voffA);
            PG8_WAIT_V(8); PG8_WAIT_L(0); PG8_BAR; PG8_MMA(0, 0, At, B0); PG8_MMA(0, 1, At, B1); PG8_BAR; PG8_SCHED;
            PG8_LDA(At, 0, 1); PG8_STAGE(PG8_SB(0, 0), b2, voffB); PG8_STAGE(PG8_SB(0, 1), b2 + hstep, voffB); PG8_STAGE(PG8_SA(0, 0), a2, voffA);
            PG8_WAIT_V(8); PG8_WAIT_L(0); PG8_BAR; PG8_MMA(1, 0, At, B0); PG8_MMA(1, 1, At, B1); PG8_BAR; PG8_SCHED;
            PG8_LDB(B0, 1, 0); PG8_LDB(B1, 1, 1); PG8_SCHED; PG8_LDA(At, 1, 0); PG8_STAGE(PG8_SA(0, 1), a2 + hstep, voffA);
            PG8_WAIT_V(8); PG8_WAIT_L(0); PG8_BAR; PG8_MMA(0, 0, At, B0); PG8_MMA(0, 1, At, B1); PG8_BAR; PG8_SCHED;
            PG8_LDA(At, 1, 1); PG8_STAGE(PG8_SB(1, 0), b3, voffB); PG8_STAGE(PG8_SB(1, 1), b3 + hstep, voffB); PG8_STAGE(PG8_SA(1, 0), a3, voffA);
            PG8_WAIT_V(8); PG8_WAIT_L(0); PG8_BAR; PG8_MMA(1, 0, At, B0); PG8_MMA(1, 1, At, B1); PG8_BAR; PG8_SCHED;
            } else {
            PG8_LDB(B0, 0, 0); PG8_SCHED; PG8_LDA(At, 0, 0); PG8_STAGE(PG8_SA(1, 1), a1 + hstep, voffA);
            PG8_WAIT_L(8); PG8_BAR; PG8_WAIT_L(0); PG8_MMA(0, 0, At, B0); PG8_BAR; PG8_SCHED;
            PG8_LDB(B1, 0, 1); PG8_STAGE(PG8_SB(0, 0), b2, voffB);
            PG8_BAR; PG8_WAIT_L(0); PG8_MMA(0, 1, At, B1); PG8_BAR;
            PG8_LDA(At, 0, 1); PG8_STAGE(PG8_SA(0, 0), a2, voffA);
            PG8_BAR; PG8_WAIT_L(0); PG8_MMA(1, 0, At, B0); PG8_BAR; PG8_SCHED;
            PG8_STAGE(PG8_SB(0, 1), b2 + hstep, voffB);
            PG8_WAIT_V(6); PG8_BAR; PG8_MMA(1, 1, At, B1); PG8_BAR;
            PG8_LDB(B0, 1, 0); PG8_SCHED; PG8_LDA(At, 1, 0); PG8_STAGE(PG8_SA(0, 1), a2 + hstep, voffA);
            PG8_WAIT_L(8); PG8_BAR; PG8_WAIT_L(0); PG8_MMA(0, 0, At, B0); PG8_BAR; PG8_SCHED;
            PG8_LDB(B1, 1, 1); PG8_STAGE(PG8_SB(1, 0), b3, voffB);
            PG8_BAR; PG8_WAIT_L(0); PG8_MMA(0, 1, At, B1); PG8_BAR;
            PG8_LDA(At, 1, 1); PG8_STAGE(PG8_SA(1, 0), a3, voffA);
            PG8_BAR; PG8_WAIT_L(0); PG8_MMA(1, 0, At, B0); PG8_BAR; PG8_SCHED;
            PG8_STAGE(PG8_SB(1, 1), b3 + hstep, voffB);
            PG8_WAIT_V(6); PG8_BAR; PG8_MMA(1, 1, At, B1); PG8_BAR;
            }
        }
        if constexpr (ALIGN_EPI) { if (wr == 0) PG8_BAR; }
        if constexpr (!Epi::AFTER_DRAIN) { E(acc, cur, wr, wc, fr, fq); S.done(cur); }
        if (!has_next) break;
#pragma unroll
        for (int a = 0; a < 2; ++a)
#pragma unroll
            for (int b = 0; b < 2; ++b)
#pragma unroll
                for (int m = 0; m < 4; ++m)
#pragma unroll
                    for (int n = 0; n < 2; ++n) acc[a][b][m][n] = (f32x4){0.f, 0.f, 0.f, 0.f};
        cur = nxt; cA = nA; cB = nB; ++ui;
        if constexpr (ALIGN_EPI) { if (wr == 1) PG8_BAR; }
    }
    PG8_WAIT_V(0);
    if constexpr (!ALIGN_EPI) { if (wr == 0) PG8_BAR; }
    PG8_BAR;
    if constexpr (Epi::AFTER_DRAIN) { E.fused(acc, cur, wr, wc, fr, fq, lds, wid, lane); S.done(cur); }
#undef PG8_SA
#undef PG8_SB
#undef PG8_STAGE
#undef PG8_LDA
#undef PG8_LDB
#undef PG8_MMA
#undef PG8_WAIT_V
#undef PG8_WAIT_L
#undef PG8_BAR
#undef PG8_SCHED
}
}

namespace att {
#define ALAS __attribute__((address_space(3)))
typedef unsigned short bf16_t;
typedef short bf16x8 __attribute__((ext_vector_type(8)));
typedef short s16x4 __attribute__((ext_vector_type(4)));
typedef float f32x16 __attribute__((ext_vector_type(16)));
typedef unsigned u32x4 __attribute__((ext_vector_type(4)));
typedef unsigned u32x2 __attribute__((ext_vector_type(2)));
constexpr int LDP = 5888, SEQ = 2048;
constexpr float LOG2E = 1.4426950408889634f, SC2 = 0.125f * LOG2E, NEG_INF = -__builtin_inff();
constexpr int COL_QSB = 0, COL_KSB = 512, COL_VSB = 1024, COL_QDL = 1536, COL_KDL = 2304, COL_VDL = 3072;

__device__ __forceinline__ unsigned pkbf(float lo, float hi) { typedef float f2 __attribute__((ext_vector_type(2))); typedef __bf16 b2 __attribute__((ext_vector_type(2))); f2 v = {lo, hi}; b2 b = __builtin_convertvector(v, b2); return __builtin_bit_cast(unsigned, b); }
__device__ __forceinline__ float other_half(float v) {
    const unsigned x = __float_as_uint(v); auto rr = __builtin_amdgcn_permlane32_swap(x, x, false, false); return __uint_as_float(rr[0] ^ rr[1] ^ x); }

struct TileRegs { u32x4 k[8], v[8]; };
__device__ __forceinline__ void load_tile(TileRegs& R, const bf16_t* kp, const bf16_t* vp, int kbase, int kstride, int lane) {
    const int l3 = lane >> 3, c = lane & 7;
#pragma unroll
    for (int it = 0; it < 8; ++it) { int t = kbase + kstride * (it * 8 + l3); t = t < 0 ? 0 : (t > SEQ - 1 ? SEQ - 1 : t);
        const size_t off = (size_t)t * LDP + c * 8; R.k[it] = *(const u32x4*)(kp + off); R.v[it] = *(const u32x4*)(vp + off); }
}
__device__ __forceinline__ void store_tile(const TileRegs& R, ALAS unsigned char* Kl, ALAS unsigned char* Vl, int lane) {
    const int l3 = lane >> 3, c = lane & 7;
    ALAS unsigned char* kb = Kl + (c >> 1) * 2048 + (c & 1) * 1024 + ((l3 ^ c) * 16);
    ALAS unsigned char* vb = Vl + (c >> 2) * 4096 + (c & 3) * 16 + l3 * 64;
#pragma unroll
    for (int it = 0; it < 8; ++it) { *(ALAS u32x4*)(kb + (it >> 2) * 512 + (it & 3) * 128) = R.k[it]; *(ALAS u32x4*)(vb + (it >> 1) * 1024 + (it & 1) * 512) = R.v[it]; }
}
__device__ __forceinline__ void qk(f32x16& p0, f32x16& p1, const ALAS unsigned char* Kl, const bf16x8 (&qf)[4], int lane) {
    const int key32 = lane & 31, h = lane >> 5;
    const f32x16 z = {0.f, 0.f, 0.f, 0.f, 0.f, 0.f, 0.f, 0.f, 0.f, 0.f, 0.f, 0.f, 0.f, 0.f, 0.f, 0.f}; p0 = z; p1 = z;
#pragma unroll
    for (int ds = 0; ds < 4; ++ds) { const int c = 2 * ds + h; const ALAS unsigned char* a = Kl + ds * 2048 + h * 1024 + ((key32 ^ c) * 16);
        const bf16x8 a0 = *(const ALAS bf16x8*)a, a1 = *(const ALAS bf16x8*)(a + 512);
        p0 = __builtin_amdgcn_mfma_f32_32x32x16_bf16(a0, qf[ds], p0, 0, 0, 0); p1 = __builtin_amdgcn_mfma_f32_32x32x16_bf16(a1, qf[ds], p1, 0, 0, 0); }
}
typedef short v4i16_t __attribute__((ext_vector_type(4)));
__device__ __forceinline__ s16x4 vtr(ALAS unsigned char* p) { return __builtin_bit_cast(s16x4, __builtin_amdgcn_ds_read_tr16_b64_v4i16((ALAS v4i16_t*)p)); }
__device__ __forceinline__ void pv(f32x16 (&o)[2], const f32x16& p0, const f32x16& p1, ALAS unsigned char* Vl, int lane) {
    const int h = lane >> 5;
    ALAS unsigned char* vb = Vl + (4 * h + ((lane & 15) >> 2)) * 64 + ((lane >> 4) & 1) * 32 + (lane & 3) * 8;
#pragma unroll
    for (int s = 0; s < 4; ++s) {
        u32x4 w;
        if (s < 2) { const int r0 = 8 * (s & 1); w.x = pkbf(p0[r0], p0[r0 + 1]); w.y = pkbf(p0[r0 + 2], p0[r0 + 3]); w.z = pkbf(p0[r0 + 4], p0[r0 + 5]); w.w = pkbf(p0[r0 + 6], p0[r0 + 7]); }
        else { const int r0 = 8 * (s & 1); w.x = pkbf(p1[r0], p1[r0 + 1]); w.y = pkbf(p1[r0 + 2], p1[r0 + 3]); w.z = pkbf(p1[r0 + 4], p1[r0 + 5]); w.w = pkbf(p1[r0 + 6], p1[r0 + 7]); }
        const bf16x8 pb = __builtin_bit_cast(bf16x8, w);
#pragma unroll
        for (int db = 0; db < 2; ++db) { const s16x4 lo = vtr(vb + db * 4096 + s * 1024), hi = vtr(vb + db * 4096 + s * 1024 + 512);
            const bf16x8 va = (bf16x8){lo[0], lo[1], lo[2], lo[3], hi[0], hi[1], hi[2], hi[3]};
            o[db] = __builtin_amdgcn_mfma_f32_32x32x16_bf16(va, pb, o[db], 0, 0, 0); }
    }
}
__device__ __forceinline__ void store_o(const f32x16 (&o)[2], float scale, bf16_t* orow, int lane) {
    const int h = lane >> 5;
#pragma unroll
    for (int db = 0; db < 2; ++db)
#pragma unroll
        for (int g = 0; g < 4; ++g) { u32x2 w; w.x = pkbf(o[db][4 * g] * scale, o[db][4 * g + 1] * scale); w.y = pkbf(o[db][4 * g + 2] * scale, o[db][4 * g + 3] * scale);
            *(u32x2*)(orow + 32 * db + 8 * g + 4 * h) = w; }
}
#define ATT_LDS_WAIT() asm volatile("s_waitcnt lgkmcnt(0)" ::: "memory")

__device__ __forceinline__ void sb_step(f32x16& p0, f32x16& p1, float& C, int dq, int tq, int lane) {
    const int h = lane >> 5;
    f32x16 L0, L1;
#pragma unroll
    for (int hf = 0; hf < 2; ++hf)
#pragma unroll
        for (int r = 0; r < 16; ++r) { const int dist = dq - (32 * hf + (r & 3) + 8 * (r >> 2)); const bool valid = (unsigned)(dist - 1) < (unsigned)tq;
            const float z2 = (hf ? p1[r] : p0[r]) * SC2;
            const float lg = __builtin_amdgcn_logf(1.0f + __builtin_amdgcn_exp2f(-__builtin_fabsf(z2)));
            const float sp = __builtin_fmaxf(z2, 0.f) + lg;
            const float Lv = valid ? -sp : 0.f, lb = valid ? (z2 - sp) : NEG_INF;
            if (hf) { L1[r] = Lv; p1[r] = lb; } else { L0[r] = Lv; p0[r] = lb; } }
    float Town[8], Toth[8];
#pragma unroll
    for (int idx = 0; idx < 8; ++idx) { const int rq = idx & 3;
        if (idx < 4) { const float s3 = L0[4 * rq + 3], s2 = s3 + L0[4 * rq + 2], s1 = s2 + L0[4 * rq + 1]; Town[idx] = s1 + L0[4 * rq]; L0[4 * rq + 3] = 0.f; L0[4 * rq + 2] = s3; L0[4 * rq + 1] = s2; L0[4 * rq] = s1; }
        else { const float s3 = L1[4 * rq + 3], s2 = s3 + L1[4 * rq + 2], s1 = s2 + L1[4 * rq + 1]; Town[idx] = s1 + L1[4 * rq]; L1[4 * rq + 3] = 0.f; L1[4 * rq + 2] = s3; L1[4 * rq + 1] = s2; L1[4 * rq] = s1; }
        Toth[idx] = other_half(Town[idx]); }
    float run = C; const float w0 = h ? 0.f : 1.f;
#pragma unroll
    for (int idx = 7; idx >= 0; --idx) { const int rq = idx & 3; const float SG = __builtin_fmaf(Toth[idx], w0, run); run += Town[idx] + Toth[idx];
#pragma unroll
        for (int e = 0; e < 4; ++e) { if (idx < 4) p0[4 * rq + e] = __builtin_amdgcn_exp2f(p0[4 * rq + e] + (SG + L0[4 * rq + e])); else p1[4 * rq + e] = __builtin_amdgcn_exp2f(p1[4 * rq + e] + (SG + L1[4 * rq + e])); } }
    C = run;
}
__device__ __forceinline__ void sb_tile(const bf16_t* proj, bf16_t* osb, int b, int hd, int q0, ALAS unsigned char* Kl, ALAS unsigned char* Vl, int lane) {
    const size_t rowbase = (size_t)b * SEQ; const int qi = lane & 31, h = lane >> 5, tq = q0 + qi;
    const bf16_t* qp = proj + rowbase * LDP + COL_QSB + hd * 64; const bf16_t* kp = proj + rowbase * LDP + COL_KSB + hd * 64; const bf16_t* vp = proj + rowbase * LDP + COL_VSB + hd * 64;
    bf16x8 qf[4];
#pragma unroll
    for (int ds = 0; ds < 4; ++ds) qf[ds] = *(const bf16x8*)(qp + (size_t)tq * LDP + 16 * ds + 8 * h);
    const f32x16 z = {0.f, 0.f, 0.f, 0.f, 0.f, 0.f, 0.f, 0.f, 0.f, 0.f, 0.f, 0.f, 0.f, 0.f, 0.f, 0.f};
    f32x16 o[2]; o[0] = z; o[1] = z; float C = 0.f; int kbase = q0 - 32;
    TileRegs R; load_tile(R, kp, vp, kbase, 1, lane);
    for (;;) {
        store_tile(R, Kl, Vl, lane);
        const int kbn = kbase - 64; const bool more = (kbn + 63 >= 0);
        if (more) load_tile(R, kp, vp, kbn, 1, lane);
        ATT_LDS_WAIT();
        f32x16 p0, p1; qk(p0, p1, Kl, qf, lane);
        sb_step(p0, p1, C, tq - kbase - 4 * h, tq, lane);
        pv(o, p0, p1, Vl, lane);
        if (!more) break;
#if SB_EARLY_EXIT
        if (__all(C < -153.0f)) break;
#endif
        kbase = kbn;
    }
    store_o(o, 1.0f, osb + (rowbase + tq) * 512 + hd * 64, lane);
}

template <int KS, int DMASK>
__device__ __forceinline__ void dil_step(f32x16& p0, f32x16& p1, f32x16 (&o)[2], float& m, float& l, int dq, int lim, float nslope2, int lane) {
    float rm = NEG_INF;
#pragma unroll
    for (int hf = 0; hf < 2; ++hf)
#pragma unroll
        for (int r = 0; r < 16; ++r) { const int dist = dq - KS * (32 * hf + (r & 3) + 8 * (r >> 2)); bool valid = (unsigned)dist <= (unsigned)lim; if (DMASK) valid = valid && ((dist & DMASK) == 0);
            float s = __builtin_fmaf((float)dist, nslope2, (hf ? p1[r] : p0[r]) * SC2); s = valid ? s : NEG_INF; rm = __builtin_fmaxf(rm, s);
            if (hf) p1[r] = s; else p0[r] = s; }
    rm = __builtin_fmaxf(rm, other_half(rm));
    const float mn = __builtin_fmaxf(m, rm), alpha = __builtin_amdgcn_exp2f(m - mn); m = mn;
    float ls = 0.f;
#pragma unroll
    for (int r = 0; r < 16; ++r) { p0[r] = __builtin_amdgcn_exp2f(p0[r] - mn); p1[r] = __builtin_amdgcn_exp2f(p1[r] - mn); ls += p0[r] + p1[r]; }
    l = l * alpha + ls;
#pragma unroll
    for (int r = 0; r < 16; ++r) { o[0][r] *= alpha; o[1][r] *= alpha; }
}
template <int G>
__device__ __forceinline__ void dil_group(const bf16_t* projb, int j, int r4, int i0, int tq, f32x16 (&o)[2], float& m, float& l, ALAS unsigned char* Kl, ALAS unsigned char* Vl, int lane) {
    constexpr int KS = (G == 0) ? 1 : 4, DMASK = (G == 2) ? 15 : 0, W = (G == 0) ? 128 : (G == 1 ? 512 : 2048);
    const int h = lane >> 5, head = 4 * G + j;
    const bf16_t* qp = projb + COL_QDL + head * 64; const bf16_t* kp = projb + COL_KDL + head * 64; const bf16_t* vp = projb + COL_VDL + head * 64;
    const float nslope2 = -LOG2E * __builtin_amdgcn_exp2f(-(float)(head + 1) * (8.0f / 12.0f));
    const int lim = tq < W ? tq : W;
    const int nt = (G == 0) ? 4 : (G == 1 ? 3 : ((i0 + 32 + 63) >> 6));
    const int kb0 = (G == 0) ? (r4 + 4 * i0 - 128) : (G == 1 ? (r4 + 4 * (i0 - 128)) : r4);
    bf16x8 qf[4];
#pragma unroll
    for (int ds = 0; ds < 4; ++ds) qf[ds] = *(const bf16x8*)(qp + (size_t)tq * LDP + 16 * ds + 8 * h);
    TileRegs R; load_tile(R, kp, vp, kb0, KS, lane);
    for (int kt = 0; kt < nt; ++kt) {
        const int kbase = kb0 + KS * 64 * kt;
        store_tile(R, Kl, Vl, lane);
        if (kt + 1 < nt) load_tile(R, kp, vp, kbase + KS * 64, KS, lane);
        ATT_LDS_WAIT();
        f32x16 p0, p1; qk(p0, p1, Kl, qf, lane);
        dil_step<KS, DMASK>(p0, p1, o, m, l, tq - kbase - KS * 4 * h, lim, nslope2, lane);
        pv(o, p0, p1, Vl, lane);
    }
}
__device__ __forceinline__ void dil_tile(const bf16_t* proj, bf16_t* odl, int b, int j, int r4, int i0, ALAS unsigned char* Kl, ALAS unsigned char* Vl, int lane) {
    const size_t rowbase = (size_t)b * SEQ; const int qi = lane & 31, tq = r4 + 4 * (i0 + qi);
    const bf16_t* projb = proj + rowbase * LDP;
    const f32x16 z = {0.f, 0.f, 0.f, 0.f, 0.f, 0.f, 0.f, 0.f, 0.f, 0.f, 0.f, 0.f, 0.f, 0.f, 0.f, 0.f};
    f32x16 o[2]; o[0] = z; o[1] = z; float m = -1.0e30f, l = 0.f;
    dil_group<0>(projb, j, r4, i0, tq, o, m, l, Kl, Vl, lane);
    dil_group<1>(projb, j, r4, i0, tq, o, m, l, Kl, Vl, lane);
    dil_group<2>(projb, j, r4, i0, tq, o, m, l, Kl, Vl, lane);
    const float lt = l + other_half(l);
    store_o(o, 1.0f / lt, odl + (rowbase + tq) * 256 + j * 64, lane);
}
__device__ __forceinline__ void mixer_phase(const bf16_t* proj, bf16_t* osb, bf16_t* odl, ALAS unsigned char* lds, int gw, int ngw, int wid, int lane) {
    ALAS unsigned char* Kl = lds + wid * 16384; ALAS unsigned char* Vl = Kl + 8192;
    for (int u = gw; u < 4096; u += ngw) { int i0i = u & 15; const int rest = u >> 4; if (rest & 128) i0i = 15 - i0i;
        dil_tile(proj, odl, rest >> 4, (rest >> 2) & 3, rest & 3, 32 * i0i, Kl, Vl, lane); }
    for (int id = gw; id < 8192; id += ngw) sb_tile(proj, osb, id >> 9, (id >> 6) & 7, (id & 63) * 32, Kl, Vl, lane);
}
}

constexpr int NWAVES = 8;
constexpr int N_LAUNCHES = MK_N_LAUNCHES;
constexpr int N_PHASES = 8;
constexpr int M = 16 * 2048, D = 1024, NIN = 5888, DFF = 2816, NFF2 = 5632, SBW = 512, DLW = 256;
constexpr size_t MiB = 1u << 20;
constexpr size_t WS_SSQ1 = 0, WS_SSQ2 = 128 * 1024;
constexpr size_t WS_WIN = 1 * MiB, WS_WSB = 13 * MiB, WS_WDL = 14 * MiB, WS_WOUT = 15 * MiB, WS_WF1 = 17 * MiB, WS_WF2 = 28 * MiB;
constexpr size_t WS_MERGED = 34 * MiB;
constexpr size_t WS_PROJ = 98 * MiB;
constexpr size_t WS_XB = WS_PROJ, WS_H = WS_PROJ + 64 * MiB;
constexpr size_t WS_END = WS_PROJ + 368 * MiB;
static_assert(WS_WIN + (size_t)NIN * D * 2 <= WS_WSB && WS_WF1 + (size_t)NFF2 * D * 2 <= WS_WF2 && WS_WF2 + (size_t)D * DFF * 2 <= WS_MERGED && WS_H + (size_t)M * DFF * 2 <= WS_END && (size_t)M * NIN * 2 <= 368 * MiB, "d_ws map");
constexpr size_t OUT_U = 0, OUT_OSB = 64 * MiB, OUT_ODL = 96 * MiB;
constexpr int LDS_BYTES = 131072;

#define LAS __attribute__((address_space(3)))
typedef unsigned short bf16;
typedef unsigned v4u __attribute__((ext_vector_type(4)));
typedef float f32x4 __attribute__((ext_vector_type(4)));
#define LDS_WAIT() asm volatile("s_waitcnt lgkmcnt(0)" ::: "memory")

__device__ __forceinline__ float wave_sum(float v) {
#pragma unroll
    for (int o = 1; o < 64; o <<= 1) v += __shfl_xor(v, o);
    return v;
}
__device__ __forceinline__ void transpose_item(const float* W, int K, int N, bf16* WT, const float* gain, int mode, LAS float* scr, int item, int lane) {
    const int nblk = N / 32, kb = item / nblk, nb = item % nblk, k0 = 64 * kb, n0 = 32 * nb;
#pragma unroll 8
    for (int i = 0; i < 32; ++i) { const int kk = 2 * i + (lane >> 5); float w = W[(size_t)(k0 + kk) * N + n0 + (lane & 31)]; if (gain) w *= gain[k0 + kk]; scr[kk * 33 + (lane & 31)] = w; }
    LDS_WAIT(); asm volatile("" ::: "memory");
    int rb = n0; if (mode == 1) { rb = (n0 < DFF) ? ((n0 >> 7) * 256 + (n0 & 127)) : ((((n0 - DFF) >> 7) * 256) + 128 + ((n0 - DFF) & 127)); }
    const int c = lane & 7;
#pragma unroll
    for (int j = 0; j < 4; ++j) { const int n = (lane >> 3) + 8 * j; const LAS float* s = scr + (8 * c) * 33 + n;
        v4u o; o.x = pg8::pkbf(s[0 * 33], s[1 * 33]); o.y = pg8::pkbf(s[2 * 33], s[3 * 33]); o.z = pg8::pkbf(s[4 * 33], s[5 * 33]); o.w = pg8::pkbf(s[6 * 33], s[7 * 33]);
        *(v4u*)(WT + (size_t)(rb + n) * K + k0 + 8 * c) = o; }
    LDS_WAIT(); asm volatile("" ::: "memory");
}

struct Args { const float* in[10]; float* out; unsigned char* ws; int ph_lo, ph_hi; };
static_assert(sizeof(Args) == 10 * 8 + 8 + 8 + 8, "Args has no padding");

__global__ void __launch_bounds__(NWAVES * 64, 2) mixer_fwd(Args args) {
    extern __shared__ __attribute__((aligned(16))) unsigned char lds_raw[];
    LAS unsigned char* lds = (LAS unsigned char*)lds_raw;
    const int tid = threadIdx.x, lane = tid & 63, wid = __builtin_amdgcn_readfirstlane(tid >> 6);
    const int G = gridDim.x, gw = blockIdx.x * NWAVES + wid, NGW = G * NWAVES;
    const float* x = args.in[0]; const float* g_mix = args.in[1]; const float* w_in = args.in[2]; const float* w_sb = args.in[3]; const float* w_dl = args.in[4];
    const float* w_out = args.in[5]; const float* g_ffn = args.in[6]; const float* w_f1 = args.in[7]; const float* w_f2 = args.in[8]; const float* g_fin = args.in[9];
    unsigned char* ws = args.ws; unsigned char* ob = (unsigned char*)args.out; float* out = args.out;
    float* ssq1 = (float*)(ws + WS_SSQ1); float* ssq2 = (float*)(ws + WS_SSQ2);
    bf16* WIN = (bf16*)(ws + WS_WIN); bf16* WSB = (bf16*)(ws + WS_WSB); bf16* WDL = (bf16*)(ws + WS_WDL); bf16* WOUT = (bf16*)(ws + WS_WOUT); bf16* WF1 = (bf16*)(ws + WS_WF1); bf16* WF2 = (bf16*)(ws + WS_WF2);
    bf16* MERGED = (bf16*)(ws + WS_MERGED); bf16* PROJ = (bf16*)(ws + WS_PROJ); bf16* XB = (bf16*)(ws + WS_XB); bf16* HB = (bf16*)(ws + WS_H);
    bf16* U = (bf16*)(ob + OUT_U); bf16* OSB = (bf16*)(ob + OUT_OSB); bf16* ODL = (bf16*)(ob + OUT_ODL);
    const int lo = args.ph_lo, hi = args.ph_hi;
#define IN(k) (lo <= (k) && (k) < hi)
#define SEAM(k) do { if (IN(k) && IN((k) + 1)) { cg::this_grid().sync(); } } while (0)

    if (IN(0)) {
        LAS float* scr = (LAS float*)(lds + wid * 16384);
        constexpr int I_IN = (D / 64) * (NIN / 32), I_SB = (SBW / 64) * (D / 32), I_DL = (DLW / 64) * (D / 32), I_OUT = (D / 64) * (D / 32), I_F1 = (D / 64) * (NFF2 / 32), I_F2 = (DFF / 64) * (D / 32);
        constexpr int NITEMS = I_IN + I_SB + I_DL + I_OUT + I_F1 + I_F2;
        for (int it = gw; it < NITEMS; it += NGW) {
            int r = it;
            if (r < I_IN) { transpose_item(w_in, D, NIN, WIN, nullptr, 0, scr, r, lane); continue; } r -= I_IN;
            if (r < I_SB) { transpose_item(w_sb, SBW, D, WSB, nullptr, 0, scr, r, lane); continue; } r -= I_SB;
            if (r < I_DL) { transpose_item(w_dl, DLW, D, WDL, nullptr, 0, scr, r, lane); continue; } r -= I_DL;
            if (r < I_OUT) { transpose_item(w_out, D, D, WOUT, nullptr, 0, scr, r, lane); continue; } r -= I_OUT;
            if (r < I_F1) { transpose_item(w_f1, D, NFF2, WF1, g_ffn, 1, scr, r, lane); continue; } r -= I_F1;
            transpose_item(w_f2, DFF, D, WF2, nullptr, 0, scr, r, lane);
        }
        for (int i = blockIdx.x * (NWAVES * 64) + tid; i < M; i += G * NWAVES * 64) { ssq1[i] = 0.f; ssq2[i] = 0.f; }
        f32x4 gv[4];
#pragma unroll
        for (int j = 0; j < 4; ++j) gv[j] = ((const f32x4*)g_mix)[lane + 64 * j];
        for (int m = gw; m < M; m += NGW) {
            const f32x4* xr = (const f32x4*)(x + (size_t)m * D) + lane; f32x4 v[4]; float s = 0.f;
#pragma unroll
            for (int j = 0; j < 4; ++j) { v[j] = xr[64 * j]; s += (v[j].x * v[j].x + v[j].y * v[j].y) + (v[j].z * v[j].z + v[j].w * v[j].w); }
            const float rstd = __builtin_amdgcn_rsqf(wave_sum(s) * (1.0f / D) + 1e-6f);
            unsigned long long* o8 = (unsigned long long*)(U + (size_t)m * D) + lane;
#pragma unroll
            for (int j = 0; j < 4; ++j) { const f32x4 y = v[j] * rstd * gv[j]; o8[64 * j] = (unsigned long long)pg8::pkbf(y.x, y.y) | ((unsigned long long)pg8::pkbf(y.z, y.w) << 32); }
        }
    }
    SEAM(0);
    if (IN(1)) {
        pg8::Gemm g{U, WIN, M, NIN, D}; pg8::StaticOrder S; S.init(M, NIN, G, (int)blockIdx.x);
        pg8::EpiStore E{PROJ, NIN};
        pg8::gemm_phase<pg8::EpiStore, pg8::StaticOrder, true, true>(lds, g, S, E);
    }
    SEAM(1);
    if (IN(2)) att::mixer_phase(PROJ, OSB, ODL, lds, gw, NGW, wid, lane);
    SEAM(2);
    if (IN(3)) {
        { pg8::Gemm g{ODL, WDL, M, D, DLW}; pg8::StaticOrder S; S.init(M, D, G, (int)blockIdx.x);
          pg8::EpiGate E{MERGED, nullptr, PROJ + 4864, NIN};
          pg8::gemm_phase<pg8::EpiGate, pg8::StaticOrder, true, true>(lds, g, S, E); }
        asm volatile("s_waitcnt vmcnt(0)" ::: "memory"); __syncthreads();
        { pg8::Gemm g{OSB, WSB, M, D, SBW}; pg8::StaticOrder S; S.init(M, D, G, (int)blockIdx.x);
          pg8::EpiGate E{MERGED, MERGED, PROJ + 3840, NIN};
          pg8::gemm_phase<pg8::EpiGate, pg8::StaticOrder, true, true>(lds, g, S, E); }
    }
    SEAM(3);
    if (IN(4)) {
        pg8::Gemm g{MERGED, WOUT, M, D, D}; pg8::StaticOrder S; S.init(M, D, G, (int)blockIdx.x);
        pg8::EpiResid<true> E{x, out, XB, ssq1};
        pg8::gemm_phase<pg8::EpiResid<true>, pg8::StaticOrder, true, true>(lds, g, S, E);
    }
    SEAM(4);
    if (IN(5)) {
        pg8::Gemm g{XB, WF1, M, NFF2, D}; pg8::StaticOrder S; S.init(M, NFF2, G, (int)blockIdx.x);
        pg8::EpiSwiGLU E{HB, ssq1};
        pg8::gemm_phase<pg8::EpiSwiGLU, pg8::StaticOrder, true, true>(lds, g, S, E);
    }
    SEAM(5);
    if (IN(6)) {
        pg8::Gemm g{HB, WF2, M, D, DFF}; pg8::StaticOrder S; S.init(M, D, G, (int)blockIdx.x);
        pg8::EpiResid<false> E{out, out, nullptr, ssq2};
        pg8::gemm_phase<pg8::EpiResid<false>, pg8::StaticOrder, true, true>(lds, g, S, E);
    }
    SEAM(6);
    if (IN(7)) {
        f32x4 gv[4];
#pragma unroll
        for (int j = 0; j < 4; ++j) gv[j] = ((const f32x4*)g_fin)[lane + 64 * j];
        for (int m = gw; m < M; m += NGW) {
            f32x4* xr = (f32x4*)(out + (size_t)m * D) + lane;
            const float rstd = __builtin_amdgcn_rsqf(ssq2[m] * (1.0f / D) + 1e-6f);
#pragma unroll
            for (int j = 0; j < 4; ++j) xr[64 * j] = xr[64 * j] * rstd * gv[j];
        }
    }
#undef IN
#undef SEAM
}

extern "C" void kernel_launch(void* const* d_in, const int* in_sizes, int n_in, void* d_out, int out_size, void* d_ws, size_t ws_size, hipStream_t stream) {
    static int grid = 0;
    if (grid == 0) {
        if (n_in != 10 || in_sizes[0] != M * D || out_size != M * D || ws_size < WS_END) { fprintf(stderr, "kernel_launch: unexpected shapes / workspace (n_in %d, in0 %d, out %d, ws %zu < %zu)\n", n_in, n_in > 0 ? in_sizes[0] : -1, out_size, ws_size, (size_t)WS_END); grid = -1; return; }
        int dev = 0, cus = 0, per_cu = 0;
        if (hipGetDevice(&dev) != hipSuccess || hipDeviceGetAttribute(&cus, hipDeviceAttributeMultiprocessorCount, dev) != hipSuccess) { fprintf(stderr, "kernel_launch: device query failed\n"); grid = -1; return; }
        if (hipFuncSetAttribute((const void*)mixer_fwd, hipFuncAttributeMaxDynamicSharedMemorySize, LDS_BYTES) != hipSuccess) { fprintf(stderr, "kernel_launch: hipFuncSetAttribute failed\n"); grid = -1; return; }
        if (hipOccupancyMaxActiveBlocksPerMultiprocessor(&per_cu, (const void*)mixer_fwd, NWAVES * 64, LDS_BYTES) != hipSuccess || per_cu < 1) { fprintf(stderr, "kernel_launch: occupancy query says %d blocks per CU\n", per_cu); (void)hipGetLastError(); grid = -1; return; }
        grid = cus;
    }
    if (grid < 0) return;
    Args a{};
    for (int i = 0; i < 10; ++i) a.in[i] = (const float*)d_in[i];
    a.out = (float*)d_out; a.ws = (unsigned char*)d_ws;
    if (N_LAUNCHES == 1) {
        a.ph_lo = 0; a.ph_hi = N_PHASES;
        void* kargs[] = {&a};
        const hipError_t e = hipLaunchCooperativeKernel((const void*)mixer_fwd, dim3(grid), dim3(NWAVES * 64), kargs, LDS_BYTES, stream);
        if (e != hipSuccess) fprintf(stderr, "kernel_launch: cooperative launch failed: %s (grid %d)\n", hipGetErrorString(e), grid);
    } else {
        for (int p = 0; p < N_PHASES; ++p) { a.ph_lo = p; a.ph_hi = p + 1; hipLaunchKernelGGL(mixer_fwd, dim3(grid), dim3(NWAVES * 64), LDS_BYTES, stream, a); }
    }
}
```

```cpp
#include <hip/hip_runtime.h>
#include <hip/hip_cooperative_groups.h>
#include <cstdio>
#include <cstdint>
namespace cg = cooperative_groups;
#ifndef MK_N_LAUNCHES
#define MK_N_LAUNCHES 1
#endif
#ifndef SB_EARLY_EXIT
#define SB_EARLY_EXIT 1
#endif
namespace pg8 {
#define PG8_LAS __attribute__((address_space(3)))
typedef unsigned short bf16_t;
typedef short bf16x8 __attribute__((ext_vector_type(8)));
typedef float f32x4 __attribute__((ext_vector_type(4)));
typedef unsigned u32x4 __attribute__((ext_vector_type(4)));
constexpr int BM = 256, BK = 64, HALF = 128, HTB = HALF * BK * 2  , STAGE_BYTES = 8 * HTB, NXCD = 8, WGM = 8;

__host__ __device__ __forceinline__ int lds_byte(int r, int c) { const int st = (r >> 4) * 2 + (c >> 5), rr = r & 15, cc = c & 31, ob = rr * 64 + cc * 2; return st * 1024 + (ob ^ (((ob >> 9) & 1) << 5)); }
__host__ __device__ __forceinline__ void stage_rc(int b, int& R, int& C) { const int st = b / 1024, sb = b % 1024, swz = sb ^ (((sb >> 9) & 1) << 5); R = (st >> 1) * 16 + swz / 64; C = (st & 1) * 32 + (swz % 64) / 2; }
__host__ __device__ __forceinline__ int perm32(int rho) { const int n = rho >> 4, i = rho & 15; return 8 * (i >> 2) + 4 * n + (i & 3); }

struct Unit { int pm, pn; };
struct Gemm { const bf16_t* A; const bf16_t* Bt; int M, N, K; };

struct StaticOrder {
    int nM, nN, nwg, G, c;
    __host__ __device__ void init(int M, int N, int G_, int c_) { nM = M / BM; nN = N / BM; nwg = nM * nN; G = G_; c = c_; }
    __host__ __device__ bool next(int i, Unit& u) const {
        const long L = (long)i * G + c; if (L >= nwg) return false;
        int wgid = (int)L; { const int q = nwg / NXCD, r = nwg % NXCD, xcd = wgid % NXCD, off = wgid / NXCD; wgid = (xcd < r ? xcd * (q + 1) : r * (q + 1) + (xcd - r) * q) + off; }
        const int nig = WGM * nN, gid = wgid / nig, fm = gid * WGM, gsz = (nM - fm) < WGM ? (nM - fm) : WGM;
        u.pm = fm + ((wgid % nig) % gsz); u.pn = (wgid % nig) / gsz; return true;
    }
    __device__ __forceinline__ void a_ready(const Unit&) const {}
    __device__ __forceinline__ void done(const Unit&) const {}
};

__device__ __forceinline__ unsigned cvt_pk_bf16(float lo, float hi) { unsigned r; asm volatile("v_cvt_pk_bf16_f32 %0, %1, %2" : "=v"(r) : "v"(lo), "v"(hi)); return r; }
typedef float f32x2 __attribute__((ext_vector_type(2)));
__device__ __forceinline__ float bflo(unsigned w) { return __uint_as_float(w << 16); }
__device__ __forceinline__ float bfhi(unsigned w) { return __uint_as_float(w & 0xffff0000u); }
__device__ __forceinline__ unsigned pkbf(float lo, float hi) { typedef float f2 __attribute__((ext_vector_type(2))); typedef __bf16 b2 __attribute__((ext_vector_type(2))); f2 v = {lo, hi}; b2 b = __builtin_convertvector(v, b2); return __builtin_bit_cast(unsigned, b); }
__device__ __forceinline__ float sigm(float x) { return __builtin_amdgcn_rcpf(1.0f + __builtin_amdgcn_exp2f(-1.4426950408889634f * x)); }
__device__ __forceinline__ u32x4 pack8(const f32x4 v0, const f32x4 v1) { u32x4 w; w.x = pkbf(v0[0], v0[1]); w.y = pkbf(v0[2], v0[3]); w.z = pkbf(v1[0], v1[1]); w.w = pkbf(v1[2], v1[3]); return w; }

struct EpiStore {
    static constexpr bool PERM = true, AFTER_DRAIN = false;
    bf16_t* O; int ldc;
    __device__ __forceinline__ void operator()(const f32x4 (&acc)[2][2][4][2], const Unit& u, int wr, int wc, int fr, int fq) const {
        const int row0 = u.pm * BM + wr * 64 + fr, col0 = u.pn * BM + wc * 32 + 8 * fq;
#pragma unroll
        for (int ai = 0; ai < 2; ++ai)
#pragma unroll
            for (int m = 0; m < 4; ++m) { bf16_t* rowp = O + (size_t)(row0 + ai * HALF + m * 16) * ldc + col0;
#pragma unroll
                for (int bj = 0; bj < 2; ++bj) *(u32x4*)(rowp + bj * HALF) = pack8(acc[ai][bj][m][0], acc[ai][bj][m][1]); }
    }
};
struct EpiGate {
    static constexpr bool PERM = true, AFTER_DRAIN = false;
    bf16_t* O; const bf16_t* add; const bf16_t* gate; int ldg;
    __device__ __forceinline__ void operator()(const f32x4 (&acc)[2][2][4][2], const Unit& u, int wr, int wc, int fr, int fq) const {
        const int row0 = u.pm * BM + wr * 64 + fr, col0 = u.pn * BM + wc * 32 + 8 * fq;
#pragma unroll
        for (int ai = 0; ai < 2; ++ai)
#pragma unroll
            for (int m = 0; m < 4; ++m) { const size_t row = (size_t)(row0 + ai * HALF + m * 16);
#pragma unroll
                for (int bj = 0; bj < 2; ++bj) { const int col = col0 + bj * HALF;
                    const u32x4 g = *(const u32x4*)(gate + row * ldg + col);
                    u32x4 a = (u32x4){0u, 0u, 0u, 0u}; if (add) a = *(const u32x4*)(add + row * 1024 + col);
                    const f32x4 v0 = acc[ai][bj][m][0], v1 = acc[ai][bj][m][1];
                    f32x4 o0, o1;
                    o0[0] = bflo(a.x) + sigm(bflo(g.x)) * v0[0]; o0[1] = bfhi(a.x) + sigm(bfhi(g.x)) * v0[1];
                    o0[2] = bflo(a.y) + sigm(bflo(g.y)) * v0[2]; o0[3] = bfhi(a.y) + sigm(bfhi(g.y)) * v0[3];
                    o1[0] = bflo(a.z) + sigm(bflo(g.z)) * v1[0]; o1[1] = bfhi(a.z) + sigm(bfhi(g.z)) * v1[1];
                    o1[2] = bflo(a.w) + sigm(bflo(g.w)) * v1[2]; o1[3] = bfhi(a.w) + sigm(bfhi(g.w)) * v1[3];
                    *(u32x4*)(O + row * 1024 + col) = pack8(o0, o1); } }
    }
};
template <bool WRITE_XB> struct EpiResid {
    static constexpr bool PERM = true, AFTER_DRAIN = false;
    const float* X; float* X1; bf16_t* XB; float* ssq;
    __device__ __forceinline__ void operator()(const f32x4 (&acc)[2][2][4][2], const Unit& u, int wr, int wc, int fr, int fq) const {
        const int row0 = u.pm * BM + wr * 64 + fr, col0 = u.pn * BM + wc * 32 + 8 * fq;
#pragma unroll
        for (int ai = 0; ai < 2; ++ai)
#pragma unroll
            for (int m = 0; m < 4; ++m) { const size_t row = (size_t)(row0 + ai * HALF + m * 16); float ss = 0.f;
#pragma unroll
                for (int bj = 0; bj < 2; ++bj) { const size_t off = row * 1024 + col0 + bj * HALF;
                    const f32x4 a = *(const f32x4*)(X + off), b = *(const f32x4*)(X + off + 4);
                    const f32x4 v0 = acc[ai][bj][m][0] + a, v1 = acc[ai][bj][m][1] + b;
                    *(f32x4*)(X1 + off) = v0; *(f32x4*)(X1 + off + 4) = v1;
                    if (WRITE_XB) *(u32x4*)(XB + off) = pack8(v0, v1);
                    ss += (v0[0] * v0[0] + v0[1] * v0[1]) + (v0[2] * v0[2] + v0[3] * v0[3]) + (v1[0] * v1[0] + v1[1] * v1[1]) + (v1[2] * v1[2] + v1[3] * v1[3]); }
                ss += __shfl_xor(ss, 16); ss += __shfl_xor(ss, 32);
                if (fq == 0) unsafeAtomicAdd(ssq + row, ss); }
    }
};
struct EpiSwiGLU {
    static constexpr bool PERM = true, AFTER_DRAIN = false;
    bf16_t* H; const float* ssq;
    __device__ __forceinline__ void operator()(const f32x4 (&acc)[2][2][4][2], const Unit& u, int wr, int wc, int fr, int fq) const {
        const int row0 = u.pm * BM + wr * 64 + fr, col0 = u.pn * HALF + wc * 32 + 8 * fq;
#pragma unroll
        for (int ai = 0; ai < 2; ++ai)
#pragma unroll
            for (int m = 0; m < 4; ++m) { const size_t row = (size_t)(row0 + ai * HALF + m * 16);
                const float rstd = __builtin_amdgcn_rsqf(ssq[row] * (1.0f / 1024.0f) + 1e-6f);
                f32x4 h0, h1;
#pragma unroll
                for (int e = 0; e < 4; ++e) { const float g0 = acc[ai][0][m][0][e] * rstd, g1 = acc[ai][0][m][1][e] * rstd;
                    h0[e] = g0 * sigm(g0) * (acc[ai][1][m][0][e] * rstd); h1[e] = g1 * sigm(g1) * (acc[ai][1][m][1][e] * rstd); }
                *(u32x4*)(H + row * 2816 + col0) = pack8(h0, h1); }
    }
};

template <class Epi, class Sched, bool ALIGN_EPI = false, bool SP2 = false>
__device__ __forceinline__ void gemm_phase(PG8_LAS unsigned char* lds, const Gemm g, const Sched& S, const Epi& E) {
    const int tid = threadIdx.x, wid = __builtin_amdgcn_readfirstlane(tid >> 6), lane = tid & 63, wr = wid >> 2, wc = wid & 3, fr = lane & 15, fq = lane >> 4;
    const int K = g.K, nt = K / BK;
    unsigned voffA[2], voffB[2];
#pragma unroll
    for (int i = 0; i < 2; ++i) { int R, C; stage_rc(tid * 16 + i * 8192, R, C); const int Rb = Epi::PERM ? ((R & ~31) + perm32(R & 31)) : R;
        voffA[i] = (unsigned)(R * K + C) * 2u; voffB[i] = (unsigned)(Rb * K + C) * 2u; }
    const size_t kstep = (size_t)(BK * 2);
    const size_t hstep = (size_t)HALF * K * 2;
    const size_t tstep = 2 * hstep;
    const unsigned ldsw = (unsigned)wid * 1024u;
    const int aoff = lds_byte(wr * 64 + fr, fq * 8), boff = lds_byte(wc * 32 + fr, fq * 8);
#define PG8_SA(b, h) (((b) * 2 + (h)) * HTB)
#define PG8_SB(b, h) ((4 + (b) * 2 + (h)) * HTB)
#define PG8_STAGE(bufoff, gbase, voff) do { _Pragma("unroll") for (int _i = 0; _i < 2; ++_i) \
        __builtin_amdgcn_global_load_lds((const unsigned*)((const char*)(gbase) + (voff)[_i]), (PG8_LAS unsigned*)(lds + (bufoff) + ldsw + _i * 8192), 16, 0, 0); } while (0)
#define PG8_LDA(dst, b, h) do { _Pragma("unroll") for (int m = 0; m < 4; ++m) _Pragma("unroll") for (int k = 0; k < 2; ++k) dst[m][k] = *(const PG8_LAS bf16x8*)(lds + PG8_SA(b, h) + aoff + m * 2048 + k * 1024); } while (0)
#define PG8_LDB(dst, b, h) do { _Pragma("unroll") for (int n = 0; n < 2; ++n) _Pragma("unroll") for (int k = 0; k < 2; ++k) dst[n][k] = *(const PG8_LAS bf16x8*)(lds + PG8_SB(b, h) + boff + n * 2048 + k * 1024); } while (0)
#define PG8_MMA(ai, bj, At, Bt) do { __builtin_amdgcn_s_setprio(1); _Pragma("unroll") for (int m = 0; m < 4; ++m) _Pragma("unroll") for (int n = 0; n < 2; ++n) _Pragma("unroll") for (int k = 0; k < 2; ++k) \
        acc[ai][bj][m][n] = __builtin_amdgcn_mfma_f32_16x16x32_bf16(Bt[n][k], At[m][k], acc[ai][bj][m][n], 0, 0, 0); __builtin_amdgcn_s_setprio(0); } while (0)
#define PG8_WAIT_V(n) asm volatile("s_waitcnt vmcnt(" #n ")" ::: "memory")
#define PG8_WAIT_L(n) asm volatile("s_waitcnt lgkmcnt(" #n ")" ::: "memory")
#define PG8_BAR __builtin_amdgcn_s_barrier()
#define PG8_SCHED __builtin_amdgcn_sched_barrier(0)
    Unit cur, nxt; int ui = 0;
    if (!S.next(0, cur)) return;
    f32x4 acc[2][2][4][2];
#pragma unroll
    for (int a = 0; a < 2; ++a)
#pragma unroll
        for (int b = 0; b < 2; ++b)
#pragma unroll
            for (int m = 0; m < 4; ++m)
#pragma unroll
                for (int n = 0; n < 2; ++n) acc[a][b][m][n] = (f32x4){0.f, 0.f, 0.f, 0.f};
    bf16x8 At[4][2], B0[2][2], B1[2][2];
    const char* cA = (const char*)g.A + (size_t)cur.pm * tstep; const char* cB = (const char*)g.Bt + (size_t)cur.pn * tstep;
    S.a_ready(cur);
    if constexpr (SP2) {
        PG8_STAGE(PG8_SB(0, 0), cB, voffB); PG8_STAGE(PG8_SB(0, 1), cB + hstep, voffB); PG8_STAGE(PG8_SA(0, 0), cA, voffA); PG8_STAGE(PG8_SA(0, 1), cA + hstep, voffA);
        if (wr == 1) PG8_BAR;
        PG8_WAIT_V(2); PG8_BAR;
        PG8_STAGE(PG8_SB(1, 0), cB + kstep, voffB); PG8_STAGE(PG8_SA(1, 0), cA + kstep, voffA); PG8_STAGE(PG8_SB(1, 1), cB + hstep + kstep, voffB);
        PG8_WAIT_V(6); PG8_BAR;
    } else {
        PG8_STAGE(PG8_SB(0, 0), cB, voffB); PG8_STAGE(PG8_SA(0, 0), cA, voffA); PG8_STAGE(PG8_SB(0, 1), cB + hstep, voffB); PG8_STAGE(PG8_SA(0, 1), cA + hstep, voffA);
        if (wr == 1) PG8_BAR;
        PG8_WAIT_V(4); PG8_BAR;
        PG8_STAGE(PG8_SB(1, 0), cB + kstep, voffB); PG8_STAGE(PG8_SA(1, 0), cA + kstep, voffA); PG8_STAGE(PG8_SB(1, 1), cB + hstep + kstep, voffB);
        PG8_WAIT_V(6); PG8_BAR;
    }
    for (;;) {
        const bool has_next = S.next(ui + 1, nxt);
        const char* nA = has_next ? (const char*)g.A + (size_t)nxt.pm * tstep : cA; const char* nB = has_next ? (const char*)g.Bt + (size_t)nxt.pn * tstep : cB;
        for (int t = 0; t < nt; t += 2) {
            const bool last = (t == nt - 2);
            const char* a1 = cA + (size_t)(t + 1) * kstep;
            const char* a2 = last ? nA : cA + (size_t)(t + 2) * kstep; const char* b2 = last ? nB : cB + (size_t)(t + 2) * kstep;
            const char* a3 = a2 + kstep; const char* b3 = b2 + kstep;
            if (last && has_next) S.a_ready(nxt);
            if constexpr (SP2) {
            PG8_LDB(B0, 0, 0); PG8_LDB(B1, 0, 1); PG8_SCHED; PG8_LDA(At, 0, 0); PG8_STAGE(PG8_SA(1, 1), a1 + hstep, voffA);
            PG8_WAIT_V(8); PG8_WAIT_L(0); PG8_BAR; PG8_MMA(0, 0, At, B0); PG8_MMA(0, 1, At, B1); PG8_BAR; PG8_SCHED;
            PG8_LDA(At, 0, 1); PG8_STAGE(PG8_SB(0, 0), b2, voffB); PG8_STAGE(PG8_SB(0, 1), b2 + hstep, voffB); PG8_STAGE(PG8_SA(0, 0), a2, voffA);
            PG8_WAIT_V(8); PG8_WAIT_L(0); PG8_BAR; PG8_MMA(1, 0, At, B0); PG8_MMA(1, 1, At, B1); PG8_BAR; PG8_SCHED;
            PG8_LDB(B0, 1, 0); PG8_LDB(B1, 1, 1); PG8_SCHED; PG8_LDA(At, 1, 0); PG8_STAGE(PG8_SA(0, 1), a2 + hstep, voffA);
            PG8_WAIT_V(8); PG8_WAIT_L(0); PG8_BAR; PG8_MMA(0, 0, At, B0); PG8_MMA(0, 1, At, B1); PG8_BAR; PG8_SCHED;
            PG8_LDA(At, 1, 1); PG8_STAGE(PG8_SB(1, 0), b3, voffB); PG8_STAGE(PG8_SB(1, 1), b3 + hstep, voffB); PG8_STAGE(PG8_SA(1, 0), a3, voffA);
            PG8_WAIT_V(8); PG8_WAIT_L(0); PG8_BAR; PG8_MMA(1, 0, At, B0); PG8_MMA(1, 1, At, B1); PG8_BAR; PG8_SCHED;
            } else {
            PG8_LDB(B0, 0, 0); PG8_SCHED; PG8_LDA(At, 0, 0); PG8_STAGE(PG8_SA(1, 1), a1 + hstep, voffA);
            PG8_WAIT_L(8); PG8_BAR; PG8_WAIT_L(0); PG8_MMA(0, 0, At, B0); PG8_BAR; PG8_SCHED;
            PG8_LDB(B1, 0, 1); PG8_STAGE(PG8_SB(0, 0), b2, voffB);
            PG8_BAR; PG8_WAIT_L(0); PG8_MMA(0, 1, At, B1); PG8_BAR;
            PG8_LDA(At, 0, 1); PG8_STAGE(PG8_SA(0, 0), a2, voffA);
            PG8_BAR; PG8_WAIT_L(0); PG8_MMA(1, 0, At, B0); PG8_BAR; PG8_SCHED;
            PG8_STAGE(PG8_SB(0, 1), b2 + hstep, voffB);
            PG8_WAIT_V(6); PG8_BAR; PG8_MMA(1, 1, At, B1); PG8_BAR;
            PG8_LDB(B0, 1, 0); PG8_SCHED; PG8_LDA(At, 1, 0); PG8_STAGE(PG8_SA(0, 1), a2 + hstep, voffA);
            PG8_WAIT_L(8); PG8_BAR; PG8_WAIT_L(0); PG8_MMA(0, 0, At, B0); PG8_BAR; PG8_SCHED;
            PG8_LDB(B1, 1, 1); PG8_STAGE(PG8_SB(1, 0), b3, voffB);
            PG8_BAR; PG8_WAIT_L(0); PG8_MMA(0, 1, At, B1); PG8_BAR;
            PG8_LDA(At, 1, 1); PG8_STAGE(PG8_SA(1, 0), a3, voffA);
            PG8_BAR; PG8_WAIT_L(0); PG8_MMA(1, 0, At, B0); PG8_BAR; PG8_SCHED;
            PG8_STAGE(PG8_SB(1, 1), b3 + hstep, voffB);
            PG8_WAIT_V(6); PG8_BAR; PG8_MMA(1, 1, At, B1); PG8_BAR;
            }
        }
        if constexpr (ALIGN_EPI) { if (wr == 0) PG8_BAR; }
        if constexpr (!Epi::AFTER_DRAIN) { E(acc, cur, wr, wc, fr, fq); S.done(cur); }
        if (!has_next) break;
#pragma unroll
        for (int a = 0; a < 2; ++a)
#pragma unroll
            for (int b = 0; b < 2; ++b)
#pragma unroll
                for (int m = 0; m < 4; ++m)
#pragma unroll
                    for (int n = 0; n < 2; ++n) acc[a][b][m][n] = (f32x4){0.f, 0.f, 0.f, 0.f};
        cur = nxt; cA = nA; cB = nB; ++ui;
        if constexpr (ALIGN_EPI) { if (wr == 1) PG8_BAR; }
    }
    PG8_WAIT_V(0);
    if constexpr (!ALIGN_EPI) { if (wr == 0) PG8_BAR; }
    PG8_BAR;
    if constexpr (Epi::AFTER_DRAIN) { E.fused(acc, cur, wr, wc, fr, fq, lds, wid, lane); S.done(cur); }
#undef PG8_SA
#undef PG8_SB
#undef PG8_STAGE
#undef PG8_LDA
#undef PG8_LDB
#undef PG8_MMA
#undef PG8_WAIT_V
#undef PG8_WAIT_L
#undef PG8_BAR
#undef PG8_SCHED
}
}

namespace att {
#define ALAS __attribute__((address_space(3)))
typedef unsigned short bf16_t;
typedef short bf16x8 __attribute__((ext_vector_type(8)));
typedef short s16x4 __attribute__((ext_vector_type(4)));
typedef float f32x16 __attribute__((ext_vector_type(16)));
typedef unsigned u32x4 __attribute__((ext_vector_type(4)));
typedef unsigned u32x2 __attribute__((ext_vector_type(2)));
constexpr int LDP = 5888, SEQ = 2048;
constexpr float LOG2E = 1.4426950408889634f, SC2 = 0.125f * LOG2E, NEG_INF = -__builtin_inff();
constexpr int COL_QSB = 0, COL_KSB = 512, COL_VSB = 1024, COL_QDL = 1536, COL_KDL = 2304, COL_VDL = 3072;

__device__ __forceinline__ unsigned pkbf(float lo, float hi) { typedef float f2 __attribute__((ext_vector_type(2))); typedef __bf16 b2 __attribute__((ext_vector_type(2))); f2 v = {lo, hi}; b2 b = __builtin_convertvector(v, b2); return __builtin_bit_cast(unsigned, b); }
__device__ __forceinline__ float other_half(float v) {
    const unsigned x = __float_as_uint(v); auto rr = __builtin_amdgcn_permlane32_swap(x, x, false, false); return __uint_as_float(rr[0] ^ rr[1] ^ x); }

struct TileRegs { u32x4 k[8], v[8]; };
__device__ __forceinline__ void load_tile(TileRegs& R, const bf16_t* kp, const bf16_t* vp, int kbase, int kstride, int lane) {
    const int l3 = lane >> 3, c = lane & 7;
#pragma unroll
    for (int it = 0; it < 8; ++it) { int t = kbase + kstride * (it * 8 + l3); t = t < 0 ? 0 : (t > SEQ - 1 ? SEQ - 1 : t);
        const size_t off = (size_t)t * LDP + c * 8; R.k[it] = *(const u32x4*)(kp + off); R.v[it] = *(const u32x4*)(vp + off); }
}
__device__ __forceinline__ void store_tile(const TileRegs& R, ALAS unsigned char* Kl, ALAS unsigned char* Vl, int lane) {
    const int l3 = lane >> 3, c = lane & 7;
    ALAS unsigned char* kb = Kl + (c >> 1) * 2048 + (c & 1) * 1024 + ((l3 ^ c) * 16);
    ALAS unsigned char* vb = Vl + (c >> 2) * 4096 + (c & 3) * 16 + l3 * 64;
#pragma unroll
    for (int it = 0; it < 8; ++it) { *(ALAS u32x4*)(kb + (it >> 2) * 512 + (it & 3) * 128) = R.k[it]; *(ALAS u32x4*)(vb + (it >> 1) * 1024 + (it & 1) * 512) = R.v[it]; }
}
__device__ __forceinline__ void qk(f32x16& p0, f32x16& p1, const ALAS unsigned char* Kl, const bf16x8 (&qf)[4], int lane) {
    const int key32 = lane & 31, h = lane >> 5;
    const f32x16 z = {0.f, 0.f, 0.f, 0.f, 0.f, 0.f, 0.f, 0.f, 0.f, 0.f, 0.f, 0.f, 0.f, 0.f, 0.f, 0.f}; p0 = z; p1 = z;
#pragma unroll
    for (int ds = 0; ds < 4; ++ds) { const int c = 2 * ds + h; const ALAS unsigned char* a = Kl + ds * 2048 + h * 1024 + ((key32 ^ c) * 16);
        const bf16x8 a0 = *(const ALAS bf16x8*)a, a1 = *(const ALAS bf16x8*)(a + 512);
        p0 = __builtin_amdgcn_mfma_f32_32x32x16_bf16(a0, qf[ds], p0, 0, 0, 0); p1 = __builtin_amdgcn_mfma_f32_32x32x16_bf16(a1, qf[ds], p1, 0, 0, 0); }
}
typedef short v4i16_t __attribute__((ext_vector_type(4)));
__device__ __forceinline__ s16x4 vtr(ALAS unsigned char* p) { return __builtin_bit_cast(s16x4, __builtin_amdgcn_ds_read_tr16_b64_v4i16((ALAS v4i16_t*)p)); }
__device__ __forceinline__ void pv(f32x16 (&o)[2], const f32x16& p0, const f32x16& p1, ALAS unsigned char* Vl, int lane) {
    const int h = lane >> 5;
    ALAS unsigned char* vb = Vl + (4 * h + ((lane & 15) >> 2)) * 64 + ((lane >> 4) & 1) * 32 + (lane & 3) * 8;
#pragma unroll
    for (int s = 0; s < 4; ++s) {
        u32x4 w;
        if (s < 2) { const int r0 = 8 * (s & 1); w.x = pkbf(p0[r0], p0[r0 + 1]); w.y = pkbf(p0[r0 + 2], p0[r0 + 3]); w.z = pkbf(p0[r0 + 4], p0[r0 + 5]); w.w = pkbf(p0[r0 + 6], p0[r0 + 7]); }
        else { const int r0 = 8 * (s & 1); w.x = pkbf(p1[r0], p1[r0 + 1]); w.y = pkbf(p1[r0 + 2], p1[r0 + 3]); w.z = pkbf(p1[r0 + 4], p1[r0 + 5]); w.w = pkbf(p1[r0 + 6], p1[r0 + 7]); }
        const bf16x8 pb = __builtin_bit_cast(bf16x8, w);
#pragma unroll
        for (int db = 0; db < 2; ++db) { const s16x4 lo = vtr(vb + db * 4096 + s * 1024), hi = vtr(vb + db * 4096 + s * 1024 + 512);
            const bf16x8 va = (bf16x8){lo[0], lo[1], lo[2], lo[3], hi[0], hi[1], hi[2], hi[3]};
            o[db] = __builtin_amdgcn_mfma_f32_32x32x16_bf16(va, pb, o[db], 0, 0, 0); }
    }
}
__device__ __forceinline__ void store_o(const f32x16 (&o)[2], float scale, bf16_t* orow, int lane) {
    const int h = lane >> 5;
#pragma unroll
    for (int db = 0; db < 2; ++db)
#pragma unroll
        for (int g = 0; g < 4; ++g) { u32x2 w; w.x = pkbf(o[db][4 * g] * scale, o[db][4 * g + 1] * scale); w.y = pkbf(o[db][4 * g + 2] * scale, o[db][4 * g + 3] * scale);
            *(u32x2*)(orow + 32 * db + 8 * g + 4 * h) = w; }
}
#define ATT_LDS_WAIT() asm volatile("s_waitcnt lgkmcnt(0)" ::: "memory")

__device__ __forceinline__ void sb_step(f32x16& p0, f32x16& p1, float& C, int dq, int tq, int lane) {
    const int h = lane >> 5;
    f32x16 L0, L1;
#pragma unroll
    for (int hf = 0; hf < 2; ++hf)
#pragma unroll
        for (int r = 0; r < 16; ++r) { const int dist = dq - (32 * hf + (r & 3) + 8 * (r >> 2)); const bool valid = (unsigned)(dist - 1) < (unsigned)tq;
            const float z2 = (hf ? p1[r] : p0[r]) * SC2;
            const float lg = __builtin_amdgcn_logf(1.0f + __builtin_amdgcn_exp2f(-__builtin_fabsf(z2)));
            const float sp = __builtin_fmaxf(z2, 0.f) + lg;
            const float Lv = valid ? -sp : 0.f, lb = valid ? (z2 - sp) : NEG_INF;
            if (hf) { L1[r] = Lv; p1[r] = lb; } else { L0[r] = Lv; p0[r] = lb; } }
    float Town[8], Toth[8];
#pragma unroll
    for (int idx = 0; idx < 8; ++idx) { const int rq = idx & 3;
        if (idx < 4) { const float s3 = L0[4 * rq + 3], s2 = s3 + L0[4 * rq + 2], s1 = s2 + L0[4 * rq + 1]; Town[idx] = s1 + L0[4 * rq]; L0[4 * rq + 3] = 0.f; L0[4 * rq + 2] = s3; L0[4 * rq + 1] = s2; L0[4 * rq] = s1; }
        else { const float s3 = L1[4 * rq + 3], s2 = s3 + L1[4 * rq + 2], s1 = s2 + L1[4 * rq + 1]; Town[idx] = s1 + L1[4 * rq]; L1[4 * rq + 3] = 0.f; L1[4 * rq + 2] = s3; L1[4 * rq + 1] = s2; L1[4 * rq] = s1; }
        Toth[idx] = other_half(Town[idx]); }
    float run = C; const float w0 = h ? 0.f : 1.f;
#pragma unroll
    for (int idx = 7; idx >= 0; --idx) { const int rq = idx & 3; const float SG = __builtin_fmaf(Toth[idx], w0, run); run += Town[idx] + Toth[idx];
#pragma unroll
        for (int e = 0; e < 4; ++e) { if (idx < 4) p0[4 * rq + e] = __builtin_amdgcn_exp2f(p0[4 * rq + e] + (SG + L0[4 * rq + e])); else p1[4 * rq + e] = __builtin_amdgcn_exp2f(p1[4 * rq + e] + (SG + L1[4 * rq + e])); } }
    C = run;
}
__device__ __forceinline__ void sb_tile(const bf16_t* proj, bf16_t* osb, int b, int hd, int q0, ALAS unsigned char* Kl, ALAS unsigned char* Vl, int lane) {
    const size_t rowbase = (size_t)b * SEQ; const int qi = lane & 31, h = lane >> 5, tq = q0 + qi;
    const bf16_t* qp = proj + rowbase * LDP + COL_QSB + hd * 64; const bf16_t* kp = proj + rowbase * LDP + COL_KSB + hd * 64; const bf16_t* vp = proj + rowbase * LDP + COL_VSB + hd * 64;
    bf16x8 qf[4];
#pragma unroll
    for (int ds = 0; ds < 4; ++ds) qf[ds] = *(const bf16x8*)(qp + (size_t)tq * LDP + 16 * ds + 8 * h);
    const f32x16 z = {0.f, 0.f, 0.f, 0.f, 0.f, 0.f, 0.f, 0.f, 0.f, 0.f, 0.f, 0.f, 0.f, 0.f, 0.f, 0.f};
    f32x16 o[2]; o[0] = z; o[1] = z; float C = 0.f; int kbase = q0 - 32;
    TileRegs R; load_tile(R, kp, vp, kbase, 1, lane);
    for (;;) {
        store_tile(R, Kl, Vl, lane);
        const int kbn = kbase - 64; const bool more = (kbn + 63 >= 0);
        if (more) load_tile(R, kp, vp, kbn, 1, lane);
        ATT_LDS_WAIT();
        f32x16 p0, p1; qk(p0, p1, Kl, qf, lane);
        sb_step(p0, p1, C, tq - kbase - 4 * h, tq, lane);
        pv(o, p0, p1, Vl, lane);
        if (!more) break;
#if SB_EARLY_EXIT
        if (__all(C < -153.0f)) break;
#endif
        kbase = kbn;
    }
    store_o(o, 1.0f, osb + (rowbase + tq) * 512 + hd * 64, lane);
}

template <int KS, int DMASK>
__device__ __forceinline__ void dil_step(f32x16& p0, f32x16& p1, f32x16 (&o)[2], float& m, float& l, int dq, int lim, float nslope2, int lane) {
    float rm = NEG_INF;
#pragma unroll
    for (int hf = 0; hf < 2; ++hf)
#pragma unroll
        for (int r = 0; r < 16; ++r) { const int dist = dq - KS * (32 * hf + (r & 3) + 8 * (r >> 2)); bool valid = (unsigned)dist <= (unsigned)lim; if (DMASK) valid = valid && ((dist & DMASK) == 0);
            float s = __builtin_fmaf((float)dist, nslope2, (hf ? p1[r] : p0[r]) * SC2); s = valid ? s : NEG_INF; rm = __builtin_fmaxf(rm, s);
            if (hf) p1[r] = s; else p0[r] = s; }
    rm = __builtin_fmaxf(rm, other_half(rm));
    const float mn = __builtin_fmaxf(m, rm), alpha = __builtin_amdgcn_exp2f(m - mn); m = mn;
    float ls = 0.f;
#pragma unroll
    for (int r = 0; r < 16; ++r) { p0[r] = __builtin_amdgcn_exp2f(p0[r] - mn); p1[r] = __builtin_amdgcn_exp2f(p1[r] - mn); ls += p0[r] + p1[r]; }
    l = l * alpha + ls;
#pragma unroll
    for (int r = 0; r < 16; ++r) { o[0][r] *= alpha; o[1][r] *= alpha; }
}
template <int G>
__device__ __forceinline__ void dil_group(const bf16_t* projb, int j, int r4, int i0, int tq, f32x16 (&o)[2], float& m, float& l, ALAS unsigned char* Kl, ALAS unsigned char* Vl, int lane) {
    constexpr int KS = (G == 0) ? 1 : 4, DMASK = (G == 2) ? 15 : 0, W = (G == 0) ? 128 : (G == 1 ? 512 : 2048);
    const int h = lane >> 5, head = 4 * G + j;
    const bf16_t* qp = projb + COL_QDL + head * 64; const bf16_t* kp = projb + COL_KDL + head * 64; const bf16_t* vp = projb + COL_VDL + head * 64;
    const float nslope2 = -LOG2E * __builtin_amdgcn_exp2f(-(float)(head + 1) * (8.0f / 12.0f));
    const int lim = tq < W ? tq : W;
    const int nt = (G == 0) ? 4 : (G == 1 ? 3 : ((i0 + 32 + 63) >> 6));
    const int kb0 = (G == 0) ? (r4 + 4 * i0 - 128) : (G == 1 ? (r4 + 4 * (i0 - 128)) : r4);
    bf16x8 qf[4];
#pragma unroll
    for (int ds = 0; ds < 4; ++ds) qf[ds] = *(const bf16x8*)(qp + (size_t)tq * LDP + 16 * ds + 8 * h);
    TileRegs R; load_tile(R, kp, vp, kb0, KS, lane);
    for (int kt = 0; kt < nt; ++kt) {
        const int kbase = kb0 + KS * 64 * kt;
        store_tile(R, Kl, Vl, lane);
        if (kt + 1 < nt) load_tile(R, kp, vp, kbase + KS * 64, KS, lane);
        ATT_LDS_WAIT();
        f32x16 p0, p1; qk(p0, p1, Kl, qf, lane);
        dil_step<KS, DMASK>(p0, p1, o, m, l, tq - kbase - KS * 4 * h, lim, nslope2, lane);
        pv(o, p0, p1, Vl, lane);
    }
}
__device__ __forceinline__ void dil_tile(const bf16_t* proj, bf16_t* odl, int b, int j, int r4, int i0, ALAS unsigned char* Kl, ALAS unsigned char* Vl, int lane) {
    const size_t rowbase = (size_t)b * SEQ; const int qi = lane & 31, tq = r4 + 4 * (i0 + qi);
    const bf16_t* projb = proj + rowbase * LDP;
    const f32x16 z = {0.f, 0.f, 0.f, 0.f, 0.f, 0.f, 0.f, 0.f, 0.f, 0.f, 0.f, 0.f, 0.f, 0.f, 0.f, 0.f};
    f32x16 o[2]; o[0] = z; o[1] = z; float m = -1.0e30f, l = 0.f;
    dil_group<0>(projb, j, r4, i0, tq, o, m, l, Kl, Vl, lane);
    dil_group<1>(projb, j, r4, i0, tq, o, m, l, Kl, Vl, lane);
    dil_group<2>(projb, j, r4, i0, tq, o, m, l, Kl, Vl, lane);
    const float lt = l + other_half(l);
    store_o(o, 1.0f / lt, odl + (rowbase + tq) * 256 + j * 64, lane);
}
__device__ __forceinline__ void mixer_phase(const bf16_t* proj, bf16_t* osb, bf16_t* odl, ALAS unsigned char* lds, int gw, int ngw, int wid, int lane) {
    ALAS unsigned char* Kl = lds + wid * 16384; ALAS unsigned char* Vl = Kl + 8192;
    for (int u = gw; u < 4096; u += ngw) { int i0i = u & 15; const int rest = u >> 4; if (rest & 128) i0i = 15 - i0i;
        dil_tile(proj, odl, rest >> 4, (rest >> 2) & 3, rest & 3, 32 * i0i, Kl, Vl, lane); }
    for (int id = gw; id < 8192; id += ngw) sb_tile(proj, osb, id >> 9, (id >> 6) & 7, (id & 63) * 32, Kl, Vl, lane);
}
}

constexpr int NWAVES = 8;
constexpr int N_LAUNCHES = MK_N_LAUNCHES;
constexpr int N_PHASES = 8;
constexpr int M = 16 * 2048, D = 1024, NIN = 5888, DFF = 2816, NFF2 = 5632, SBW = 512, DLW = 256;
constexpr size_t MiB = 1u << 20;
constexpr size_t WS_SSQ1 = 0, WS_SSQ2 = 128 * 1024;
constexpr size_t WS_WIN = 1 * MiB, WS_WSB = 13 * MiB, WS_WDL = 14 * MiB, WS_WOUT = 15 * MiB, WS_WF1 = 17 * MiB, WS_WF2 = 28 * MiB;
constexpr size_t WS_MERGED = 34 * MiB;
constexpr size_t WS_PROJ = 98 * MiB;
constexpr size_t WS_XB = WS_PROJ, WS_H = WS_PROJ + 64 * MiB;
constexpr size_t WS_END = WS_PROJ + 368 * MiB;
static_assert(WS_WIN + (size_t)NIN * D * 2 <= WS_WSB && WS_WF1 + (size_t)NFF2 * D * 2 <= WS_WF2 && WS_WF2 + (size_t)D * DFF * 2 <= WS_MERGED && WS_H + (size_t)M * DFF * 2 <= WS_END && (size_t)M * NIN * 2 <= 368 * MiB, "d_ws map");
constexpr size_t OUT_U = 0, OUT_OSB = 64 * MiB, OUT_ODL = 96 * MiB;
constexpr int RING_BYTES = 131072, MISC_OFF = RING_BYTES, LDS_BYTES = RING_BYTES + 64;
constexpr size_t WS_BAR = 256 * 1024, BAR_BYTES = 16 * 1024;

#define LAS __attribute__((address_space(3)))
typedef unsigned short bf16;
typedef unsigned v4u __attribute__((ext_vector_type(4)));
typedef float f32x4 __attribute__((ext_vector_type(4)));
#define LDS_WAIT() asm volatile("s_waitcnt lgkmcnt(0)" ::: "memory")
#define XB_TMO      128
#define XB_XCNT(j)  (256  + 64 * (j))
#define XB_XSUB(j)  (1280 + 64 * (j))
#define XB_XGEN(j)  (2304 + 64 * (j))
#define XB_TOP      3328
#define XB_TOPGEN   3392
#define XCD_BAR_WORDS 3456
#define XB_SPIN_CAP (1u << 18)

__device__ __forceinline__ unsigned xb_ld(unsigned* p)              { return __hip_atomic_load(p, __ATOMIC_RELAXED, __HIP_MEMORY_SCOPE_AGENT); }
__device__ __forceinline__ unsigned xb_add(unsigned* p, unsigned v) { return __hip_atomic_fetch_add(p, v, __ATOMIC_RELAXED, __HIP_MEMORY_SCOPE_AGENT); }
__device__ __forceinline__ unsigned xb_xcc_id() { return (unsigned)__builtin_amdgcn_s_getreg((3 << 11) | 20) & 0xFu; }
#define XB_SPIN(cond, bar) do { unsigned _sp = 0; while (cond) { __builtin_amdgcn_s_sleep(1); \
    if ((++_sp & 255u) == 0u) { if (xb_ld(&(bar)[XB_TMO])) break; if (_sp > XB_SPIN_CAP) { atomicAdd(&(bar)[XB_TMO], 1u); break; } } } } while (0)

struct XcdBarrier {
    unsigned* bar; unsigned x;
    volatile LAS unsigned* st;
};

__device__ __forceinline__ XcdBarrier xcd_barrier_post(unsigned* bar, volatile LAS unsigned* st) {
    XcdBarrier b; b.bar = bar; b.x = xb_xcc_id(); b.st = st;
    if (threadIdx.x == 0) (void)xb_add(&bar[XB_XCNT(b.x)], 1u);
    return b;
}
__device__ __forceinline__ void xcd_barrier_complete(unsigned* bar, unsigned x, unsigned& nloc, unsigned& nx) {
    const unsigned G = gridDim.x * gridDim.y * gridDim.z;
    unsigned sum, cnt, mine, sp = 0u;
    for (;;) {
        sum = 0u; cnt = 0u; mine = 0u;
#pragma unroll
        for (unsigned j = 0; j < 16; ++j) { const unsigned c = xb_ld(&bar[XB_XCNT(j)]); sum += c; cnt += (c > 0u) ? 1u : 0u; mine = (j == x) ? c : mine; }
        if (sum == G) break;
        __builtin_amdgcn_s_sleep(1);
        if ((++sp & 255u) == 0u) { if (xb_ld(&bar[XB_TMO])) break; if (sp > XB_SPIN_CAP) { atomicAdd(&bar[XB_TMO], 1u); break; } }
    }
    nloc = mine > 0u ? mine : 1u; nx = cnt > 0u ? cnt : 1u;
}

__device__ __forceinline__ void xcd_barrier(const XcdBarrier& b) {
    asm volatile("s_waitcnt vmcnt(0)" ::: "memory");
    __syncthreads();
    if (threadIdx.x == 0) {
        unsigned* bar = b.bar;
        __builtin_amdgcn_s_waitcnt(0);
        unsigned nloc = b.st[0], nx = b.st[1];
        if (nloc == 0u) { xcd_barrier_complete(bar, b.x, nloc, nx); b.st[0] = nloc; b.st[1] = nx; }
        const unsigned old = xb_add(&bar[XB_XSUB(b.x)], 1u);
        const unsigned gen = old / nloc;
        if (old + 1u == (gen + 1u) * nloc) {
            __builtin_amdgcn_fence(__ATOMIC_RELEASE, "agent");
            asm volatile("s_waitcnt vmcnt(0)" ::: "memory");
            const unsigned og = xb_add(&bar[XB_TOP], 1u);
            const unsigned tg = og / nx;
            if (og + 1u == (tg + 1u) * nx) xb_add(&bar[XB_TOPGEN], 1u);
            else XB_SPIN(xb_ld(&bar[XB_TOPGEN]) == tg, bar);
            __builtin_amdgcn_fence(__ATOMIC_ACQUIRE, "agent");
            xb_add(&bar[XB_XGEN(b.x)], 1u);
            asm volatile("s_waitcnt vmcnt(0)" ::: "memory");
        } else {
            XB_SPIN(xb_ld(&bar[XB_XGEN(b.x)]) == gen, bar);
            __builtin_amdgcn_fence(__ATOMIC_ACQUIRE, "agent");
            asm volatile("s_waitcnt vmcnt(0)" ::: "memory");
        }
    }
    __syncthreads();
}

__device__ __forceinline__ float wave_sum(float v) {
#pragma unroll
    for (int o = 1; o < 64; o <<= 1) v += __shfl_xor(v, o);
    return v;
}
__device__ __forceinline__ void transpose_item(const float* W, int K, int N, bf16* WT, const float* gain, int mode, LAS float* scr, int item, int lane) {
    const int nblk = N / 32, kb = item / nblk, nb = item % nblk, k0 = 64 * kb, n0 = 32 * nb;
#pragma unroll 8
    for (int i = 0; i < 32; ++i) { const int kk = 2 * i + (lane >> 5); float w = W[(size_t)(k0 + kk) * N + n0 + (lane & 31)]; if (gain) w *= gain[k0 + kk]; scr[kk * 33 + (lane & 31)] = w; }
    LDS_WAIT(); asm volatile("" ::: "memory");
    int rb = n0; if (mode == 1) { rb = (n0 < DFF) ? ((n0 >> 7) * 256 + (n0 & 127)) : ((((n0 - DFF) >> 7) * 256) + 128 + ((n0 - DFF) & 127)); }
    const int c = lane & 7;
#pragma unroll
    for (int j = 0; j < 4; ++j) { const int n = (lane >> 3) + 8 * j; const LAS float* s = scr + (8 * c) * 33 + n;
        v4u o; o.x = pg8::pkbf(s[0 * 33], s[1 * 33]); o.y = pg8::pkbf(s[2 * 33], s[3 * 33]); o.z = pg8::pkbf(s[4 * 33], s[5 * 33]); o.w = pg8::pkbf(s[6 * 33], s[7 * 33]);
        *(v4u*)(WT + (size_t)(rb + n) * K + k0 + 8 * c) = o; }
    LDS_WAIT(); asm volatile("" ::: "memory");
}

struct Args { const float* in[10]; float* out; unsigned char* ws; int ph_lo, ph_hi; };
static_assert(sizeof(Args) == 10 * 8 + 8 + 8 + 8, "Args has no padding");

__global__ void __launch_bounds__(NWAVES * 64, 2) mixer_fwd(Args args) {
    extern __shared__ __attribute__((aligned(16))) unsigned char lds_raw[];
    LAS unsigned char* lds = (LAS unsigned char*)lds_raw;
    const int tid = threadIdx.x, lane = tid & 63, wid = __builtin_amdgcn_readfirstlane(tid >> 6);
    const int G = gridDim.x, gw = blockIdx.x * NWAVES + wid, NGW = G * NWAVES;
    const float* x = args.in[0]; const float* g_mix = args.in[1]; const float* w_in = args.in[2]; const float* w_sb = args.in[3]; const float* w_dl = args.in[4];
    const float* w_out = args.in[5]; const float* g_ffn = args.in[6]; const float* w_f1 = args.in[7]; const float* w_f2 = args.in[8]; const float* g_fin = args.in[9];
    unsigned char* ws = args.ws; unsigned char* ob = (unsigned char*)args.out; float* out = args.out;
    float* ssq1 = (float*)(ws + WS_SSQ1); float* ssq2 = (float*)(ws + WS_SSQ2);
    bf16* WIN = (bf16*)(ws + WS_WIN); bf16* WSB = (bf16*)(ws + WS_WSB); bf16* WDL = (bf16*)(ws + WS_WDL); bf16* WOUT = (bf16*)(ws + WS_WOUT); bf16* WF1 = (bf16*)(ws + WS_WF1); bf16* WF2 = (bf16*)(ws + WS_WF2);
    bf16* MERGED = (bf16*)(ws + WS_MERGED); bf16* PROJ = (bf16*)(ws + WS_PROJ); bf16* XB = (bf16*)(ws + WS_XB); bf16* HB = (bf16*)(ws + WS_H);
    bf16* U = (bf16*)(ob + OUT_U); bf16* OSB = (bf16*)(ob + OUT_OSB); bf16* ODL = (bf16*)(ob + OUT_ODL);
    const int lo = args.ph_lo, hi = args.ph_hi;
    volatile LAS unsigned* MISC = (volatile LAS unsigned*)(lds + MISC_OFF);
    if (tid < 16) MISC[tid] = 0u;
    __syncthreads();
    XcdBarrier bar; bar.bar = (unsigned*)(ws + WS_BAR); bar.x = 0; bar.st = MISC;
    if (N_LAUNCHES == 1) bar = xcd_barrier_post((unsigned*)(ws + WS_BAR), MISC);
#define IN(k) (lo <= (k) && (k) < hi)
#define SEAM(k) do { if (IN(k) && IN((k) + 1)) { if ((k) == 0) cg::this_grid().sync(); else xcd_barrier(bar); } } while (0)

    if (IN(0)) {
        LAS float* scr = (LAS float*)(lds + wid * 16384);
        constexpr int I_IN = (D / 64) * (NIN / 32), I_SB = (SBW / 64) * (D / 32), I_DL = (DLW / 64) * (D / 32), I_OUT = (D / 64) * (D / 32), I_F1 = (D / 64) * (NFF2 / 32), I_F2 = (DFF / 64) * (D / 32);
        constexpr int NITEMS = I_IN + I_SB + I_DL + I_OUT + I_F1 + I_F2;
        for (int it = gw; it < NITEMS; it += NGW) {
            int r = it;
            if (r < I_IN) { transpose_item(w_in, D, NIN, WIN, nullptr, 0, scr, r, lane); continue; } r -= I_IN;
            if (r < I_SB) { transpose_item(w_sb, SBW, D, WSB, nullptr, 0, scr, r, lane); continue; } r -= I_SB;
            if (r < I_DL) { transpose_item(w_dl, DLW, D, WDL, nullptr, 0, scr, r, lane); continue; } r -= I_DL;
            if (r < I_OUT) { transpose_item(w_out, D, D, WOUT, nullptr, 0, scr, r, lane); continue; } r -= I_OUT;
            if (r < I_F1) { transpose_item(w_f1, D, NFF2, WF1, g_ffn, 1, scr, r, lane); continue; } r -= I_F1;
            transpose_item(w_f2, DFF, D, WF2, nullptr, 0, scr, r, lane);
        }
        for (int i = blockIdx.x * (NWAVES * 64) + tid; i < M; i += G * NWAVES * 64) { ssq1[i] = 0.f; ssq2[i] = 0.f; }
        f32x4 gv[4];
#pragma unroll
        for (int j = 0; j < 4; ++j) gv[j] = ((const f32x4*)g_mix)[lane + 64 * j];
        for (int m = gw; m < M; m += NGW) {
            const f32x4* xr = (const f32x4*)(x + (size_t)m * D) + lane; f32x4 v[4]; float s = 0.f;
#pragma unroll
            for (int j = 0; j < 4; ++j) { v[j] = xr[64 * j]; s += (v[j].x * v[j].x + v[j].y * v[j].y) + (v[j].z * v[j].z + v[j].w * v[j].w); }
            const float rstd = __builtin_amdgcn_rsqf(wave_sum(s) * (1.0f / D) + 1e-6f);
            unsigned long long* o8 = (unsigned long long*)(U + (size_t)m * D) + lane;
#pragma unroll
            for (int j = 0; j < 4; ++j) { const f32x4 y = v[j] * rstd * gv[j]; o8[64 * j] = (unsigned long long)pg8::pkbf(y.x, y.y) | ((unsigned long long)pg8::pkbf(y.z, y.w) << 32); }
        }
    }
    SEAM(0);
    if (IN(1)) {
        pg8::Gemm g{U, WIN, M, NIN, D}; pg8::StaticOrder S; S.init(M, NIN, G, (int)blockIdx.x);
        pg8::EpiStore E{PROJ, NIN};
        pg8::gemm_phase<pg8::EpiStore, pg8::StaticOrder, true, true>(lds, g, S, E);
    }
    SEAM(1);
    if (IN(2)) att::mixer_phase(PROJ, OSB, ODL, lds, gw, NGW, wid, lane);
    SEAM(2);
    if (IN(3)) {
        { pg8::Gemm g{ODL, WDL, M, D, DLW}; pg8::StaticOrder S; S.init(M, D, G, (int)blockIdx.x);
          pg8::EpiGate E{MERGED, nullptr, PROJ + 4864, NIN};
          pg8::gemm_phase<pg8::EpiGate, pg8::StaticOrder, true, true>(lds, g, S, E); }
        asm volatile("s_waitcnt vmcnt(0)" ::: "memory"); __syncthreads();
        { pg8::Gemm g{OSB, WSB, M, D, SBW}; pg8::StaticOrder S; S.init(M, D, G, (int)blockIdx.x);
          pg8::EpiGate E{MERGED, MERGED, PROJ + 3840, NIN};
          pg8::gemm_phase<pg8::EpiGate, pg8::StaticOrder, true, true>(lds, g, S, E); }
    }
    SEAM(3);
    if (IN(4)) {
        pg8::Gemm g{MERGED, WOUT, M, D, D}; pg8::StaticOrder S; S.init(M, D, G, (int)blockIdx.x);
        pg8::EpiResid<true> E{x, out, XB, ssq1};
        pg8::gemm_phase<pg8::EpiResid<true>, pg8::StaticOrder, true, true>(lds, g, S, E);
    }
    SEAM(4);
    if (IN(5)) {
        pg8::Gemm g{XB, WF1, M, NFF2, D}; pg8::StaticOrder S; S.init(M, NFF2, G, (int)blockIdx.x);
        pg8::EpiSwiGLU E{HB, ssq1};
        pg8::gemm_phase<pg8::EpiSwiGLU, pg8::StaticOrder, true, true>(lds, g, S, E);
    }
    SEAM(5);
    if (IN(6)) {
        pg8::Gemm g{HB, WF2, M, D, DFF}; pg8::StaticOrder S; S.init(M, D, G, (int)blockIdx.x);
        pg8::EpiResid<false> E{out, out, nullptr, ssq2};
        pg8::gemm_phase<pg8::EpiResid<false>, pg8::StaticOrder, true, true>(lds, g, S, E);
    }
    SEAM(6);
    if (IN(7)) {
        f32x4 gv[4];
#pragma unroll
        for (int j = 0; j < 4; ++j) gv[j] = ((const f32x4*)g_fin)[lane + 64 * j];
        for (int m = gw; m < M; m += NGW) {
            f32x4* xr = (f32x4*)(out + (size_t)m * D) + lane;
            const float rstd = __builtin_amdgcn_rsqf(ssq2[m] * (1.0f / D) + 1e-6f);
#pragma unroll
            for (int j = 0; j < 4; ++j) xr[64 * j] = xr[64 * j] * rstd * gv[j];
        }
    }
#undef IN
#undef SEAM
}

extern "C" void kernel_launch(void* const* d_in, const int* in_sizes, int n_in, void* d_out, int out_size, void* d_ws, size_t ws_size, hipStream_t stream) {
    static int grid = 0;
    if (grid == 0) {
        if (n_in != 10 || in_sizes[0] != M * D || out_size != M * D || ws_size < WS_END) { fprintf(stderr, "kernel_launch: unexpected shapes / workspace (n_in %d, in0 %d, out %d, ws %zu < %zu)\n", n_in, n_in > 0 ? in_sizes[0] : -1, out_size, ws_size, (size_t)WS_END); grid = -1; return; }
        int dev = 0, cus = 0, per_cu = 0;
        if (hipGetDevice(&dev) != hipSuccess || hipDeviceGetAttribute(&cus, hipDeviceAttributeMultiprocessorCount, dev) != hipSuccess) { fprintf(stderr, "kernel_launch: device query failed\n"); grid = -1; return; }
        if (hipFuncSetAttribute((const void*)mixer_fwd, hipFuncAttributeMaxDynamicSharedMemorySize, LDS_BYTES) != hipSuccess) { fprintf(stderr, "kernel_launch: hipFuncSetAttribute failed\n"); grid = -1; return; }
        if (hipOccupancyMaxActiveBlocksPerMultiprocessor(&per_cu, (const void*)mixer_fwd, NWAVES * 64, LDS_BYTES) != hipSuccess || per_cu < 1) { fprintf(stderr, "kernel_launch: occupancy query says %d blocks per CU\n", per_cu); (void)hipGetLastError(); grid = -1; return; }
        grid = cus;
    }
    if (grid < 0) return;
    Args a{};
    for (int i = 0; i < 10; ++i) a.in[i] = (const float*)d_in[i];
    a.out = (float*)d_out; a.ws = (unsigned char*)d_ws;
    if (N_LAUNCHES == 1) {
        if (hipMemsetAsync((char*)d_ws + WS_BAR, 0, BAR_BYTES, stream) != hipSuccess) { fprintf(stderr, "kernel_launch: memset of barrier words failed\n"); return; }
        a.ph_lo = 0; a.ph_hi = N_PHASES;
        void* kargs[] = {&a};
        const hipError_t e = hipLaunchCooperativeKernel((const void*)mixer_fwd, dim3(grid), dim3(NWAVES * 64), kargs, LDS_BYTES, stream);
        if (e != hipSuccess) fprintf(stderr, "kernel_launch: cooperative launch failed: %s (grid %d)\n", hipGetErrorString(e), grid);
    } else {
        for (int p = 0; p < N_PHASES; ++p) { a.ph_lo = p; a.ph_hi = p + 1; hipLaunchKernelGGL(mixer_fwd, dim3(grid), dim3(NWAVES * 64), LDS_BYTES, stream, a); }
    }
}
```
